# Optimizing an MI355X kernel written in HIP

```python
import jax, jax.numpy as jnp
from jax import lax
import numpy as np

D_MODEL = 2048
BATCH = 4
SEQ = 2048
DEPTH = 1

N_META = 16
CHUNK = 128
MIX_DIM = D_MODEL
N_RET_HEADS = 8
RET_HEAD_DIM = 128
RET_DIM = N_RET_HEADS * RET_HEAD_DIM
N_FOX_HEADS = 8
FOX_HEAD_DIM = 128
FOX_DIM = N_FOX_HEADS * FOX_HEAD_DIM
IN_DIM = 4 * RET_DIM + 3 * FOX_DIM + N_FOX_HEADS
D_FF = 5632
CONV_WIDTH = 3
ROPE_BASE = 10000.0
NORM_EPS = 1e-6

kernel_name = "hymba_retention_fox_convffn_block"


def _rmsnorm(x, gain):
    x32 = x.astype(jnp.float32)
    y = x32 * lax.rsqrt(jnp.mean(x32 * x32, axis=-1, keepdims=True) + NORM_EPS)
    return (y * gain.astype(jnp.float32)).astype(x.dtype)


def _heads(t, n_heads):
    b, l, _ = t.shape
    return t.reshape(b, l, n_heads, -1).transpose(0, 2, 1, 3)


def _rotary(t, pos):
    d = t.shape[-1]
    inv_freq = 1.0 / (ROPE_BASE ** (jnp.arange(0, d, 2, dtype=jnp.float32) / d))
    ang = pos[:, None] * inv_freq[None, :]
    cos, sin = jnp.cos(ang), jnp.sin(ang)
    t1, t2 = t[..., : d // 2], t[..., d // 2:]
    return jnp.concatenate([t1 * cos - t2 * sin, t1 * sin + t2 * cos], axis=-1)


def _decay_matrix(log_g, n):
    idx = jnp.arange(n, dtype=jnp.float32)
    diff = idx[:, None] - idx[None, :]
    return jnp.where(diff >= 0, jnp.exp(jnp.maximum(diff, 0.0)[None] * log_g[:, None, None]), 0.0)


def _ret_intra(q, k, v, dmat):
    s = jnp.einsum('bhid,bhjd->bhij', q, k) * dmat[None]
    return jnp.einsum('bhij,bhjv->bhiv', s, v)


def _retention(q, k, v, log_g):
    b, h, l, dv = v.shape
    m = N_META
    out_m = _ret_intra(q[:, :, :m], k[:, :, :m], v[:, :, :m], _decay_matrix(log_g, m))
    zeta_m = jnp.exp((m - 1 - jnp.arange(m, dtype=jnp.float32))[None, :] * log_g[:, None])
    state0 = jnp.einsum('bhjd,bhjv,hj->bhdv', k[:, :, :m], v[:, :, :m], zeta_m)
    n_chunks = (l - m) // CHUNK

    def to_chunks(t):
        return t[:, :, m:].reshape(b, h, n_chunks, CHUNK, t.shape[-1]).transpose(2, 0, 1, 3, 4)

    pos_c = jnp.arange(CHUNK, dtype=jnp.float32)
    d_c = _decay_matrix(log_g, CHUNK)
    xi = jnp.exp((pos_c + 1.0)[None, :] * log_g[:, None])
    zeta = jnp.exp((CHUNK - 1.0 - pos_c)[None, :] * log_g[:, None])
    g_chunk = jnp.exp(CHUNK * log_g)[None, :, None, None]

    def step(state, qkv):
        qc, kc, vc = qkv
        o = _ret_intra(qc, kc, vc, d_c) + jnp.einsum('bhid,bhdv,hi->bhiv', qc, state, xi)
        state = g_chunk * state + jnp.einsum('bhjd,bhjv,hj->bhdv', kc, vc, zeta)
        return state, o

    _, o = lax.scan(step, state0, (to_chunks(q), to_chunks(k), to_chunks(v)))
    o = o.transpose(1, 2, 0, 3, 4).reshape(b, h, n_chunks * CHUNK, dv)
    return jnp.concatenate([out_m, o], axis=2)


def _forgetting_attention(q, k, v, log_f):
    l = q.shape[2]
    scale = q.shape[-1] ** -0.5
    cum = jnp.cumsum(log_f, axis=-1)
    bounds = [0, N_META] + [N_META + CHUNK * (i + 1) for i in range((l - N_META) // CHUNK)]
    outs = []
    for s, e in zip(bounds[:-1], bounds[1:]):
        logits = jnp.einsum('bhqd,bhkd->bhqk', q[:, :, s:e], k[:, :, :e]).astype(jnp.float32) * scale
        logits = logits + cum[:, :, s:e, None] - cum[:, :, None, :e]
        causal = jnp.arange(s, e)[:, None] >= jnp.arange(e)[None, :]
        p = jax.nn.softmax(jnp.where(causal[None, None], logits, -jnp.inf), axis=-1)
        outs.append(jnp.einsum('bhqk,bhkd->bhqd', p.astype(v.dtype), v[:, :, :e]))
    return jnp.concatenate(outs, axis=2)


def _head_groupnorm(o, gain):
    mu = jnp.mean(o, axis=-1, keepdims=True)
    var = jnp.mean(jnp.square(o - mu), axis=-1, keepdims=True)
    y = (o - mu) * lax.rsqrt(var + NORM_EPS)
    b, h, l, d = o.shape
    return y.transpose(0, 2, 1, 3).reshape(b, l, h * d) * gain.astype(jnp.float32)


def _causal_dwconv(u, w, bias):
    kw = w.shape[0]
    l = u.shape[1]
    up = jnp.pad(u, ((0, 0), (kw - 1, 0), (0, 0)))
    y = bias
    for i in range(kw):
        y = y + w[i] * up[:, i:i + l]
    return y


def setup_inputs(seed: int = 0) -> dict:
    key = jax.random.key(seed)
    ks = jax.random.split(key, 16)
    f32 = jnp.float32
    x = jax.random.normal(ks[0], (BATCH, SEQ, D_MODEL), f32)
    meta_tokens = jax.random.normal(ks[1], (N_META, D_MODEL), f32)
    norm1_gain = 1.0 + 0.01 * jax.random.normal(ks[2], (DEPTH, D_MODEL), f32)
    w_in = jax.random.normal(ks[3], (DEPTH, D_MODEL, IN_DIM), f32) * D_MODEL ** -0.5
    b_forget = (jnp.linspace(1.0, 5.0, N_FOX_HEADS, dtype=f32)[None, :]
                + 0.1 * jax.random.normal(ks[4], (DEPTH, N_FOX_HEADS), f32))
    ret_norm_gain = 1.0 + 0.01 * jax.random.normal(ks[5], (DEPTH, RET_DIM), f32)
    w_out = jax.random.normal(ks[6], (DEPTH, MIX_DIM, D_MODEL), f32) * MIX_DIM ** -0.5
    norm2_gain = 1.0 + 0.01 * jax.random.normal(ks[7], (DEPTH, D_MODEL), f32)
    w_up = jax.random.normal(ks[8], (DEPTH, D_MODEL, 2 * D_FF), f32) * D_MODEL ** -0.5
    conv_w = jax.random.normal(ks[9], (DEPTH, CONV_WIDTH, 2 * D_FF), f32) * CONV_WIDTH ** -0.5
    conv_b = 0.01 * jax.random.normal(ks[10], (DEPTH, 2 * D_FF), f32)
    w_down = jax.random.normal(ks[11], (DEPTH, D_FF, D_MODEL), f32) * D_FF ** -0.5
    final_norm_gain = 1.0 + 0.01 * jax.random.normal(ks[12], (D_MODEL,), f32)
    return {"x": x, "meta_tokens": meta_tokens, "norm1_gain": norm1_gain, "w_in": w_in,
            "b_forget": b_forget, "ret_norm_gain": ret_norm_gain, "w_out": w_out,
            "norm2_gain": norm2_gain, "w_up": w_up, "conv_w": conv_w, "conv_b": conv_b,
            "w_down": w_down, "final_norm_gain": final_norm_gain}


def reference(x, meta_tokens, norm1_gain, w_in, b_forget, ret_norm_gain, w_out,
              norm2_gain, w_up, conv_w, conv_b, w_down, final_norm_gain):
    b = x.shape[0]
    f32 = jnp.float32
    h = jnp.concatenate([jnp.broadcast_to(meta_tokens[None].astype(x.dtype), (b, N_META, D_MODEL)), x], axis=1)
    l = h.shape[1]
    pos = jnp.arange(l, dtype=f32)
    log_g = jnp.log1p(-jnp.exp2(-5.0 - jnp.arange(N_RET_HEADS, dtype=f32)))
    split_at = np.cumsum([RET_DIM] * 4 + [FOX_DIM] * 3)[:].tolist()

    for layer in range(DEPTH):
        a = _rmsnorm(h, norm1_gain[layer])
        proj = a @ w_in[layer]
        r_q, r_k, r_v, r_g, f_q, f_k, f_v, f_f = jnp.split(proj, split_at, axis=-1)

        rq = _rotary(_heads(r_q, N_RET_HEADS).astype(f32), pos)
        rk = _rotary(_heads(r_k, N_RET_HEADS).astype(f32), pos) * RET_HEAD_DIM ** -0.5
        rv = _heads(r_v, N_RET_HEADS).astype(f32)
        ret = _head_groupnorm(_retention(rq, rk, rv, log_g), ret_norm_gain[layer])
        ret = (jax.nn.silu(r_g.astype(f32)) * ret).astype(x.dtype)

        log_f = jax.nn.log_sigmoid(f_f.astype(f32) + b_forget[layer].astype(f32)).transpose(0, 2, 1)
        fox = _forgetting_attention(_heads(f_q, N_FOX_HEADS), _heads(f_k, N_FOX_HEADS),
                                    _heads(f_v, N_FOX_HEADS), log_f)
        fox = fox.transpose(0, 2, 1, 3).reshape(b, l, FOX_DIM).astype(x.dtype)

        h = h + jnp.concatenate([ret, fox], axis=-1) @ w_out[layer]

        c = _rmsnorm(h, norm2_gain[layer])
        u = _causal_dwconv(c @ w_up[layer], conv_w[layer], conv_b[layer])
        gate, val = jnp.split(u, 2, axis=-1)
        h = h + (jax.nn.silu(gate) * val) @ w_down[layer]

    out = _rmsnorm(h, final_norm_gain)
    return out[:, N_META:]
```

```cpp
#include <hip/hip_runtime.h>
#include <hip/hip_cooperative_groups.h>
#include <cstdio>
#include <cstdint>
namespace cg = cooperative_groups;

#define LAS __attribute__((address_space(3)))
typedef unsigned short bf16_t;
typedef short bf16x8 __attribute__((ext_vector_type(8)));
typedef short s16x4 __attribute__((ext_vector_type(4)));
typedef float f32x2 __attribute__((ext_vector_type(2)));
typedef float f32x4 __attribute__((ext_vector_type(4)));
typedef float f32x16 __attribute__((ext_vector_type(16)));
typedef unsigned u32x2 __attribute__((ext_vector_type(2)));
typedef unsigned u32x4 __attribute__((ext_vector_type(4)));

constexpr int DM = 2048, NB = 4, SEQ = 2048, NMETA = 16, LTOT = SEQ + NMETA;
constexpr int MREAL = NB * SEQ;
constexpr int MPAD = MREAL + 256;
constexpr int NH = 8, HD = 128;
constexpr int NPROJ = 7168;
constexpr int INDIM = 7176;
constexpr int DFF = 5632, NUP = 2 * DFF;
constexpr int KVP = 2112;
constexpr float EPS = 1e-6f;
constexpr int LDS_BYTES = 147456;

constexpr size_t OFF_SS2 = 0;
constexpr size_t OFF_SS3 = 65536;
constexpr size_t OFF_LOGF = 131072;
constexpr size_t OFF_IRS = 425984;
constexpr size_t OFF_COS = 524288;
constexpr size_t OFF_SIN = 1310720;
constexpr size_t OFF_DEC = 2097152;
constexpr size_t OFF_DECI = 2228224;
constexpr size_t OFF_QX = 2621440;
constexpr size_t OFF_KX = 4194304;
constexpr size_t OFF_QM = 5767168;
constexpr size_t OFF_H1M = 6029312;
constexpr size_t OFF_A = 6291456;
constexpr size_t OFF_WTIN = OFF_A;
constexpr size_t OFF_WTOUT = OFF_WTIN + (size_t)NPROJ * DM * 2;
constexpr size_t OFF_WTUP = OFF_WTOUT + (size_t)DM * DM * 2;
constexpr size_t OFF_A2 = OFF_WTUP + (size_t)NUP * DM * 2;
constexpr size_t SZ_SIDE = (size_t)132 * 4 * NUP * 2;
constexpr size_t OFF_WTDN = OFF_A2 + (size_t)MPAD * DM * 2;
constexpr size_t OFF_B = OFF_WTDN + (size_t)DM * DFF * 2;
constexpr size_t OFF_SIDE = OFF_B;
constexpr size_t OFF_ACT = OFF_B + 16777216;
constexpr size_t OFF_A1 = OFF_B;
constexpr size_t SZ_Q = (size_t)NB * NH * SEQ * HD * 2, SZ_K = (size_t)NB * NH * KVP * HD * 2;
constexpr size_t OFF_RQ = OFF_A1 + (size_t)MPAD * DM * 2;
constexpr size_t OFF_RK = OFF_RQ + SZ_Q;
constexpr size_t OFF_RV = OFF_RK + SZ_K;
constexpr size_t OFF_FQ = OFF_RV + SZ_K;
constexpr size_t OFF_FK = OFF_FQ + SZ_Q;
constexpr size_t OFF_FV = OFF_FK + SZ_K;
constexpr size_t OFF_G = OFF_FV + SZ_K;
constexpr size_t OFF_MIX = OFF_G + (size_t)MPAD * 1024 * 2;
constexpr size_t WS_END = OFF_MIX + (size_t)MPAD * DM * 2;
static_assert(OFF_MIX + (size_t)MPAD * DM * 2 <= WS_END, "region B overlay");
static_assert(OFF_ACT + (size_t)MREAL * DFF * 2 <= WS_END && SZ_SIDE <= 16777216, "act overlay");
static_assert(WS_END <= 369000000ull, "workspace");

__device__ __forceinline__ unsigned cvt_pk_bf16(float lo, float hi) { unsigned r; asm volatile("v_cvt_pk_bf16_f32 %0, %1, %2" : "=v"(r) : "v"(lo), "v"(hi)); return r; }
__device__ __forceinline__ unsigned f2bf(float f) { unsigned u = __builtin_bit_cast(unsigned, f); return (u + 0x7fffu + ((u >> 16) & 1u)) >> 16; }
__device__ __forceinline__ float bf2f(unsigned b) { return __builtin_bit_cast(float, b << 16); }
__device__ __forceinline__ unsigned pk2(float lo, float hi) { return f2bf(lo) | (f2bf(hi) << 16); }
__device__ __forceinline__ void st_wt16(void* p, u32x4 v) { asm volatile("global_store_dwordx4 %0, %1, off sc1\n\ts_nop 1" :: "v"(p), "v"(v) : "memory"); }
__device__ __forceinline__ float silu_f(float v) { return v * __builtin_amdgcn_rcpf(1.f + __builtin_amdgcn_exp2f(v * -1.4426950408889634f)); }

namespace pg8 {
constexpr int BM = 256, BK = 64, HALF = 128, HTB = HALF * BK * 2, STAGE_BYTES = 8 * HTB, NXCD = 8, WGM = 2;
__host__ __device__ __forceinline__ int lds_byte(int r, int c) { const int st = (r >> 4) * 2 + (c >> 5), rr = r & 15, cc = c & 31, ob = rr * 64 + cc * 2; return st * 1024 + (ob ^ (((ob >> 9) & 1) << 5)); }
__host__ __device__ __forceinline__ void stage_rc(int b, int& R, int& C) { const int st = b / 1024, sb = b % 1024, swz = sb ^ (((sb >> 9) & 1) << 5); R = (st >> 1) * 16 + swz / 64; C = (st & 1) * 32 + (swz % 64) / 2; }
__host__ __device__ __forceinline__ int perm32(int rho) { const int n = rho >> 4, i = rho & 15; return 8 * (i >> 2) + 4 * n + (i & 3); }
struct Unit { int pm, pn; };
struct Gemm { const bf16_t* A; const bf16_t* Bt; int M, N, K; };
struct StaticOrder {
    int nM, nN, nwg, G, c;
    __host__ __device__ void init(int M, int N, int G_, int c_) { nM = M / BM; nN = N / BM; nwg = nM * nN; G = G_; c = c_; }
    __host__ __device__ __forceinline__ bool next(int i, Unit& u) const {
        const long L = (long)i * G + c; if (L >= nwg) return false;
        int wgid = (int)L; { const int q = nwg / NXCD, r = nwg % NXCD, xcd = wgid % NXCD, off = wgid / NXCD; wgid = (xcd < r ? xcd * (q + 1) : r * (q + 1) + (xcd - r) * q) + off; }
        const int nig = WGM * nN, gid = wgid / nig, fm = gid * WGM, gsz = (nM - fm) < WGM ? (nM - fm) : WGM;
        u.pm = fm + ((wgid % nig) % gsz); u.pn = (wgid % nig) / gsz; return true;
    }
};
template <class Epi>
__device__ __forceinline__ void gemm_phase(LAS unsigned char* lds, const Gemm g, const StaticOrder& S, const Epi& E) {
    int tid = threadIdx.x; asm volatile("" : "+v"(tid));
    const int wid = __builtin_amdgcn_readfirstlane(tid >> 6), lane = tid & 63, wr = wid >> 2, wc = wid & 3, fr = lane & 15, fq = lane >> 4;
    const int K = g.K, nt = K / BK;
    unsigned voffA[2], voffB[2];
#pragma unroll
    for (int i = 0; i < 2; ++i) { int R, C; stage_rc(tid * 16 + i * 8192, R, C); const int Rb = Epi::PERM ? ((R & ~31) + perm32(R & 31)) : R;
        voffA[i] = (unsigned)(R * K + C) * 2u; voffB[i] = (unsigned)(Rb * K + C) * 2u; }
    const size_t kstep = (size_t)(BK * 2);
    const size_t hstep = (size_t)HALF * K * 2;
    const size_t tstep = 2 * hstep;
    const unsigned ldsw = (unsigned)wid * 1024u;
    const int aoff = lds_byte(wr * 64 + fr, fq * 8), boff = lds_byte(wc * 32 + fr, fq * 8);
#define PG8_SA(b, h) (((b) * 2 + (h)) * HTB)
#define PG8_SB(b, h) ((4 + (b) * 2 + (h)) * HTB)
#define PG8_STAGE(bufoff, gbase, voff) do { _Pragma("unroll") for (int _i = 0; _i < 2; ++_i) \
        __builtin_amdgcn_global_load_lds((const unsigned*)((const char*)(gbase) + (voff)[_i]), (LAS unsigned*)(lds + (bufoff) + ldsw + _i * 8192), 16, 0, 0); } while (0)
#define PG8_LDA(dst, b, h) do { _Pragma("unroll") for (int m = 0; m < 4; ++m) _Pragma("unroll") for (int k = 0; k < 2; ++k) dst[m][k] = *(const LAS bf16x8*)(lds + PG8_SA(b, h) + aoff + m * 2048 + k * 1024); } while (0)
#define PG8_LDB(dst, b, h) do { _Pragma("unroll") for (int n = 0; n < 2; ++n) _Pragma("unroll") for (int k = 0; k < 2; ++k) dst[n][k] = *(const LAS bf16x8*)(lds + PG8_SB(b, h) + boff + n * 2048 + k * 1024); } while (0)
#define PG8_MMA(ai, bj, At, Bt) do { __builtin_amdgcn_s_setprio(1); _Pragma("unroll") for (int m = 0; m < 4; ++m) _Pragma("unroll") for (int n = 0; n < 2; ++n) _Pragma("unroll") for (int k = 0; k < 2; ++k) \
        acc[ai][bj][m][n] = __builtin_amdgcn_mfma_f32_16x16x32_bf16(Bt[n][k], At[m][k], acc[ai][bj][m][n], 0, 0, 0); __builtin_amdgcn_s_setprio(0); } while (0)
#define PG8_WAIT_V(n) asm volatile("s_waitcnt vmcnt(" #n ")" ::: "memory")
#define PG8_WAIT_L(n) asm volatile("s_waitcnt lgkmcnt(" #n ")" ::: "memory")
#define PG8_BAR __builtin_amdgcn_s_barrier()
#define PG8_SCHED __builtin_amdgcn_sched_barrier(0)
    Unit cur, nxt; int ui = 0;
    if (!S.next(0, cur)) return;
    f32x4 acc[2][2][4][2];
#pragma unroll
    for (int a = 0; a < 2; ++a)
#pragma unroll
        for (int b = 0; b < 2; ++b)
#pragma unroll
            for (int m = 0; m < 4; ++m)
#pragma unroll
                for (int n = 0; n < 2; ++n) acc[a][b][m][n] = (f32x4){0.f, 0.f, 0.f, 0.f};
    bf16x8 At[4][2], B0[2][2], B1[2][2];
    const char* cA = (const char*)g.A + (size_t)cur.pm * tstep; const char* cB = (const char*)g.Bt + (size_t)cur.pn * tstep;
    PG8_STAGE(PG8_SB(0, 0), cB, voffB); PG8_STAGE(PG8_SB(0, 1), cB + hstep, voffB); PG8_STAGE(PG8_SA(0, 0), cA, voffA); PG8_STAGE(PG8_SA(0, 1), cA + hstep, voffA);
    if (wr == 1) PG8_BAR;
    PG8_WAIT_V(2); PG8_BAR;
    PG8_STAGE(PG8_SB(1, 0), cB + kstep, voffB); PG8_STAGE(PG8_SA(1, 0), cA + kstep, voffA); PG8_STAGE(PG8_SB(1, 1), cB + hstep + kstep, voffB);
    PG8_WAIT_V(6); PG8_BAR;
    for (;;) {
        const bool has_next = S.next(ui + 1, nxt);
        const char* nA = has_next ? (const char*)g.A + (size_t)nxt.pm * tstep : cA; const char* nB = has_next ? (const char*)g.Bt + (size_t)nxt.pn * tstep : cB;
        for (int t = 0; t < nt; t += 2) {
            const bool last = (t == nt - 2);
            const char* a1 = cA + (size_t)(t + 1) * kstep;
            const char* a2 = last ? nA : cA + (size_t)(t + 2) * kstep; const char* b2 = last ? nB : cB + (size_t)(t + 2) * kstep;
            const char* a3 = a2 + kstep; const char* b3 = b2 + kstep;
            PG8_LDB(B0, 0, 0); PG8_LDB(B1, 0, 1); PG8_SCHED; PG8_LDA(At, 0, 0); PG8_STAGE(PG8_SA(1, 1), a1 + hstep, voffA);
            PG8_WAIT_V(8); PG8_WAIT_L(0); PG8_BAR; PG8_MMA(0, 0, At, B0); PG8_MMA(0, 1, At, B1); PG8_BAR; PG8_SCHED;
            PG8_LDA(At, 0, 1); PG8_STAGE(PG8_SB(0, 0), b2, voffB); PG8_STAGE(PG8_SB(0, 1), b2 + hstep, voffB); PG8_STAGE(PG8_SA(0, 0), a2, voffA);
            PG8_WAIT_V(8); PG8_WAIT_L(0); PG8_BAR; PG8_MMA(1, 0, At, B0); PG8_MMA(1, 1, At, B1); PG8_BAR; PG8_SCHED;
            PG8_LDB(B0, 1, 0); PG8_LDB(B1, 1, 1); PG8_SCHED; PG8_LDA(At, 1, 0); PG8_STAGE(PG8_SA(0, 1), a2 + hstep, voffA);
            PG8_WAIT_V(8); PG8_WAIT_L(0); PG8_BAR; PG8_MMA(0, 0, At, B0); PG8_MMA(0, 1, At, B1); PG8_BAR; PG8_SCHED;
            PG8_LDA(At, 1, 1); PG8_STAGE(PG8_SB(1, 0), b3, voffB); PG8_STAGE(PG8_SB(1, 1), b3 + hstep, voffB); PG8_STAGE(PG8_SA(1, 0), a3, voffA);
            PG8_WAIT_V(8); PG8_WAIT_L(0); PG8_BAR; PG8_MMA(1, 0, At, B0); PG8_MMA(1, 1, At, B1); PG8_BAR; PG8_SCHED;
        }
        if (wr == 0) PG8_BAR;
        E(acc, cur, wr, wc, fr, fq);
        if (!has_next) break;
#pragma unroll
        for (int a = 0; a < 2; ++a)
#pragma unroll
            for (int b = 0; b < 2; ++b)
#pragma unroll
                for (int m = 0; m < 4; ++m)
#pragma unroll
                    for (int n = 0; n < 2; ++n) acc[a][b][m][n] = (f32x4){0.f, 0.f, 0.f, 0.f};
        cur = nxt; cA = nA; cB = nB; ++ui;
        if (wr == 1) PG8_BAR;
    }
    PG8_WAIT_V(0);
    PG8_BAR;
#undef PG8_SA
#undef PG8_SB
#undef PG8_STAGE
#undef PG8_LDA
#undef PG8_LDB
#undef PG8_MMA
#undef PG8_WAIT_V
#undef PG8_WAIT_L
#undef PG8_BAR
#undef PG8_SCHED
}

struct EpiProj {
    static constexpr bool PERM = true;
    unsigned char* ws;
    __device__ __forceinline__ void operator()(const f32x4 (&acc)[2][2][4][2], const Unit& u, int wr, int wc, int fr, int fq) const {
        const int region = u.pn >> 2, hp = (u.pn & 3) * 2;
        bf16_t* const RQ = (bf16_t*)(ws + OFF_RQ); bf16_t* const RK = (bf16_t*)(ws + OFF_RK); bf16_t* const RV = (bf16_t*)(ws + OFF_RV);
        bf16_t* const FQ = (bf16_t*)(ws + OFF_FQ); bf16_t* const FK = (bf16_t*)(ws + OFF_FK); bf16_t* const FV = (bf16_t*)(ws + OFF_FV);
        bf16_t* const G = (bf16_t*)(ws + OFF_G); bf16_t* const QM = (bf16_t*)(ws + OFF_QM);
        const float* const cosT = (const float*)(ws + OFF_COS); const float* const sinT = (const float*)(ws + OFF_SIN);
        const float* const dec = (const float*)(ws + OFF_DEC); const float* const deci = (const float*)(ws + OFF_DECI);
        const bool meta = (u.pm == 32);
        const int cih = 32 * wc + 8 * fq;
        const int d0 = 16 * wc + 4 * fq;
#pragma unroll
        for (int ai = 0; ai < 2; ++ai) {
          f32x4 c4v[4], s4v[4]; float fv[4][2];
          if (region <= 1) {
#pragma unroll
            for (int m = 0; m < 4; ++m) { const int rt = ai * 128 + wr * 64 + m * 16 + fr; const int row = u.pm * 256 + rt; const int pos = meta ? (rt & 15) : NMETA + (row & 2047);
                c4v[m] = *(const f32x4*)(cosT + pos * 64 + d0); s4v[m] = *(const f32x4*)(sinT + pos * 64 + d0);
                fv[m][0] = (region == 0 ? dec : deci)[hp * LTOT + pos]; fv[m][1] = (region == 0 ? dec : deci)[(hp + 1) * LTOT + pos]; }
          }
#pragma unroll
            for (int m = 0; m < 4; ++m) {
                const int rt = ai * 128 + wr * 64 + m * 16 + fr;
                if (meta && (ai | m | wr) != 0) continue;
                const int row = u.pm * 256 + rt;
                const int b = (row >> 11) & 3, s = row & 2047, pos = meta ? rt : NMETA + s;
                const f32x4 c4 = c4v[m], s4 = s4v[m];
#pragma unroll
                for (int bj = 0; bj < 2; ++bj) {
                    const int hh = hp + bj;
                    f32x4 v0 = acc[ai][bj][m][0], v1 = acc[ai][bj][m][1];
                    if (region <= 1) {
                        const float f = fv[m][bj];
                        const f32x4 o0 = (v0 * c4 - v1 * s4) * f, o1 = (v0 * s4 + v1 * c4) * f; v0 = o0; v1 = o1;
                    } else if (region == 3) {
#pragma unroll
                        for (int j = 0; j < 4; ++j) { v0[j] = silu_f(v0[j]); v1[j] = silu_f(v1[j]); }
                    }
                    u32x4 w; w.x = cvt_pk_bf16(v0[0], v0[1]); w.y = cvt_pk_bf16(v0[2], v0[3]); w.z = cvt_pk_bf16(v1[0], v1[1]); w.w = cvt_pk_bf16(v1[2], v1[3]);
                    if (region == 3) { *(u32x4*)(G + (size_t)row * 1024 + hh * 128 + cih) = w; }
                    else if (region == 0 || region == 4) {
                        if (meta) *(u32x4*)(QM + (size_t)(((region == 4 ? 8 : 0) + hh) * 16 + rt) * 128 + cih) = w;
                        else *(u32x4*)((region == 0 ? RQ : FQ) + ((size_t)(b * 8 + hh) * SEQ + s) * 128 + cih) = w;
                    } else {
                        bf16_t* base = region == 1 ? RK : region == 2 ? RV : region == 5 ? FK : FV;
                        if (meta) {
#pragma unroll
                            for (int bb = 0; bb < 4; ++bb) *(u32x4*)(base + ((size_t)(bb * 8 + hh) * KVP + pos) * 128 + cih) = w;
                        } else *(u32x4*)(base + ((size_t)(b * 8 + hh) * KVP + pos) * 128 + cih) = w;
                    }
                }
            }
        }
    }
};
struct EpiOut {
    static constexpr bool PERM = true;
    const bf16_t* A1; const float* irs; bf16_t* A2; float* ss; int dry;
    __device__ __forceinline__ void operator()(const f32x4 (&acc)[2][2][4][2], const Unit& u, int wr, int wc, int fr, int fq) const {
        const int col0 = u.pn * 256 + wc * 32 + 8 * fq;
#pragma unroll
        for (int ai = 0; ai < 2; ++ai) {
            u32x4 xv[4][2]; float ir[4];
#pragma unroll
            for (int m = 0; m < 4; ++m) { const int row = u.pm * 256 + ai * 128 + wr * 64 + m * 16 + fr; ir[m] = irs[row];
#pragma unroll
                for (int bj = 0; bj < 2; ++bj) xv[m][bj] = *(const u32x4*)(A1 + (size_t)row * DM + col0 + bj * 128); }
#pragma unroll
            for (int m = 0; m < 4; ++m) {
                const int row = u.pm * 256 + ai * 128 + wr * 64 + m * 16 + fr; const size_t off = (size_t)row * DM + col0; float q = 0.f;
#pragma unroll
                for (int bj = 0; bj < 2; ++bj) { const u32x4 xb = xv[m][bj];
                    const f32x4 x0 = (f32x4){bf2f(xb.x & 0xffffu), bf2f(xb.x >> 16), bf2f(xb.y & 0xffffu), bf2f(xb.y >> 16)} * ir[m];
                    const f32x4 x1 = (f32x4){bf2f(xb.z & 0xffffu), bf2f(xb.z >> 16), bf2f(xb.w & 0xffffu), bf2f(xb.w >> 16)} * ir[m];
                    const f32x4 h0 = x0 + acc[ai][bj][m][0], h1 = x1 + acc[ai][bj][m][1];
                    u32x4 w; w.x = cvt_pk_bf16(h0[0], h0[1]); w.y = cvt_pk_bf16(h0[2], h0[3]); w.z = cvt_pk_bf16(h1[0], h1[1]); w.w = cvt_pk_bf16(h1[2], h1[3]);
                    *(u32x4*)(A2 + off + bj * 128) = w;
                    q += ((h0[0] * h0[0] + h0[1] * h0[1]) + (h0[2] * h0[2] + h0[3] * h0[3])) + ((h1[0] * h1[0] + h1[1] * h1[1]) + (h1[2] * h1[2] + h1[3] * h1[3])); }
                q += __shfl_xor(q, 16); q += __shfl_xor(q, 32);
                if (fq == 0 && !dry) atomicAdd(ss + row, q);
            }
        }
    }
};
template <int CTRL> __device__ __forceinline__ float dpp_ror(float src) { return __builtin_bit_cast(float, __builtin_amdgcn_update_dpp(0, __builtin_bit_cast(int, src), CTRL, 0xf, 0xf, true)); }
struct EpiUp {
    static constexpr bool PERM = true;
    bf16_t* ACTp; bf16_t* SIDEp; const float* ss; const float* cw; const float* cb; LAS unsigned char* ldsx;
    __device__ __forceinline__ void side_store(int grp, int slot, int pn, int c8h, const f32x4& cG, const f32x4& cV) const {
        bf16_t* sp = SIDEp + (size_t)(grp * 4 + slot) * NUP + pn * 256 + c8h;
        u32x2 a_; a_.x = cvt_pk_bf16(cG[0], cG[1]); a_.y = cvt_pk_bf16(cG[2], cG[3]); *(u32x2*)sp = a_;
        u32x2 b_; b_.x = cvt_pk_bf16(cV[0], cV[1]); b_.y = cvt_pk_bf16(cV[2], cV[3]); *(u32x2*)(sp + 128) = b_;
    }
    __device__ __forceinline__ void operator()(const f32x4 (&acc)[2][2][4][2], const Unit& u, int wr, int wc, int fr, int fq) const {
        const int c8 = wc * 32 + 8 * fq, ch0 = u.pn * 128 + c8;
        const bool l1 = fr < 1, l2 = fr < 2, meta = u.pm == 32;
        u32x2 stash[2][4];
        LAS float* wl = (LAS float*)(ldsx + 131072 + (wr * 4 + wc) * 1024);
        { const int lane_ = fq * 16 + fr, p = lane_ >> 3, chl = 4 * (lane_ & 7), chb = u.pn * 128 + wc * 32 + chl;
          const float* src = (p & 3) == 3 ? cb + (p >> 2) * DFF + chb : cw + (p & 3) * NUP + (p >> 2) * DFF + chb;
          *(LAS f32x4*)(wl + p * 32 + chl) = *(const f32x4*)src; }
        float rsv[2][4];
#pragma unroll
        for (int ai = 0; ai < 2; ++ai)
#pragma unroll
            for (int m = 0; m < 4; ++m) rsv[ai][m] = ss[u.pm * 256 + ai * 128 + wr * 64 + m * 16 + fr];
#pragma unroll
        for (int ai = 0; ai < 2; ++ai)
#pragma unroll
            for (int m = 0; m < 4; ++m) rsv[ai][m] = __builtin_amdgcn_rsqf(rsv[ai][m] * (1.f / DM) + EPS);
#pragma unroll
        for (int half = 0; half < 2; ++half) {
            const LAS float* wq = wl + 8 * fq + 4 * half;
            const f32x4 wg0 = *(const LAS f32x4*)(wq), wg1 = *(const LAS f32x4*)(wq + 32), wg2 = *(const LAS f32x4*)(wq + 64), bg = *(const LAS f32x4*)(wq + 96);
            const f32x4 wv0 = *(const LAS f32x4*)(wq + 128), wv1 = *(const LAS f32x4*)(wq + 160), wv2 = *(const LAS f32x4*)(wq + 192), bv = *(const LAS f32x4*)(wq + 224);
#pragma unroll
            for (int ai = 0; ai < 2; ++ai) {
                f32x4 r1G = {0, 0, 0, 0}, r2G = {0, 0, 0, 0}, r1V = {0, 0, 0, 0}, r2V = {0, 0, 0, 0};
                const int grp = u.pm * 4 + ai * 2 + wr;
#pragma unroll
                for (int m = 0; m < 4; ++m) {
                    const int row = u.pm * 256 + ai * 128 + wr * 64 + m * 16 + fr; const float rs = rsv[ai][m];
                    const f32x4 cG = acc[ai][0][m][half] * rs, cV = acc[ai][1][m][half] * rs;
                    f32x4 c1G, c2G, c1V, c2V, G1, G2, V1, V2;
#pragma unroll
                    for (int j = 0; j < 4; ++j) { c1G[j] = dpp_ror<0x121>(cG[j]); c2G[j] = dpp_ror<0x122>(cG[j]); c1V[j] = dpp_ror<0x121>(cV[j]); c2V[j] = dpp_ror<0x122>(cV[j]);
                        G1[j] = l1 ? r1G[j] : c1G[j]; G2[j] = l2 ? r2G[j] : c2G[j]; V1[j] = l1 ? r1V[j] : c1V[j]; V2[j] = l2 ? r2V[j] : c2V[j]; }
                    const f32x4 yg = bg + wg0 * G2 + wg1 * G1 + wg2 * cG, yv = bv + wv0 * V2 + wv1 * V1 + wv2 * cV;
                    f32x4 res;
#pragma unroll
                    for (int j = 0; j < 4; ++j) res[j] = silu_f(yg[j]) * yv[j];
                    u32x2 pk; pk.x = cvt_pk_bf16(res[0], res[1]); pk.y = cvt_pk_bf16(res[2], res[3]);
                    if (half == 0) stash[ai][m] = pk;
                    else if (!meta && !(m == 0 && l2)) { u32x4 w; w.x = stash[ai][m].x; w.y = stash[ai][m].y; w.z = pk.x; w.w = pk.y; *(u32x4*)(ACTp + (size_t)row * DFF + ch0) = w; }
                    if (!meta) { if (m == 0) { if (l2) side_store(grp, fr, u.pn, c8 + 4 * half, cG, cV); }
                                 if (m == 3) { if (fr >= 14) side_store(grp, fr - 12, u.pn, c8 + 4 * half, cG, cV); } }
                    else if (ai == 0 && m == 0) { if (wr == 0 && fr >= 14) side_store(128, fr - 12, u.pn, c8 + 4 * half, cG, cV); }
                    r1G = c1G; r2G = c2G; r1V = c1V; r2V = c2V;
                }
            }
        }
    }
};
struct EpiDown {
    static constexpr bool PERM = true;
    float* out; const bf16_t* A2; float* ss; unsigned* cnt; const float* gf;
    __device__ __forceinline__ void operator()(f32x4 (&acc)[2][2][4][2], const Unit& u, int wr, int wc, int fr, int fq) const {
        const int col0 = u.pn * 256 + wc * 32 + 8 * fq;
#pragma unroll
        for (int ai = 0; ai < 2; ++ai) {
            f32x4 hv[4][2][2];
#pragma unroll
            for (int m = 0; m < 4; ++m)
#pragma unroll
                for (int bj = 0; bj < 2; ++bj)
#pragma unroll
                    for (int n = 0; n < 2; ++n) { const u32x2 hb = *(const u32x2*)(A2 + (size_t)(u.pm * 256 + ai * 128 + wr * 64 + m * 16 + fr) * DM + col0 + bj * 128 + n * 4);
                        hv[m][bj][n] = (f32x4){bf2f(hb.x & 0xffffu), bf2f(hb.x >> 16), bf2f(hb.y & 0xffffu), bf2f(hb.y >> 16)}; }
#pragma unroll
            for (int m = 0; m < 4; ++m) {
                const int row = u.pm * 256 + ai * 128 + wr * 64 + m * 16 + fr; float q = 0.f;
#pragma unroll
                for (int bj = 0; bj < 2; ++bj)
#pragma unroll
                    for (int n = 0; n < 2; ++n) { const f32x4 h = hv[m][bj][n] + acc[ai][bj][m][n];
                        acc[ai][bj][m][n] = h; q += (h[0] * h[0] + h[1] * h[1]) + (h[2] * h[2] + h[3] * h[3]); }
                q += __shfl_xor(q, 16); q += __shfl_xor(q, 32);
                if (fq == 0) { const float old_ = atomicAdd(ss + row, q); asm volatile("" :: "v"(old_)); }
            }
        }
        asm volatile("s_waitcnt vmcnt(0)" ::: "memory");
        __builtin_amdgcn_s_barrier();
        unsigned* c = cnt + 64 * u.pm;
        if (wr == 0 && wc == 0) {
            if ((fr | fq) == 0) __hip_atomic_fetch_add(c, 1u, __ATOMIC_RELAXED, __HIP_MEMORY_SCOPE_AGENT);
            unsigned sp = 0; while ((unsigned)__builtin_amdgcn_readfirstlane(__hip_atomic_load(c, __ATOMIC_RELAXED, __HIP_MEMORY_SCOPE_AGENT)) < 8u) { __builtin_amdgcn_s_sleep(8); if (++sp > (1u << 20)) break; }
        }
        __builtin_amdgcn_s_barrier();
        f32x4 gv[2][2];
#pragma unroll
        for (int bj = 0; bj < 2; ++bj)
#pragma unroll
            for (int n = 0; n < 2; ++n) gv[bj][n] = *(const f32x4*)(gf + col0 + bj * 128 + n * 4);
        float sv[2][4];
#pragma unroll
        for (int ai = 0; ai < 2; ++ai)
#pragma unroll
            for (int m = 0; m < 4; ++m) sv[ai][m] = __hip_atomic_load(ss + u.pm * 256 + ai * 128 + wr * 64 + m * 16 + fr, __ATOMIC_RELAXED, __HIP_MEMORY_SCOPE_AGENT);
#pragma unroll
        for (int ai = 0; ai < 2; ++ai)
#pragma unroll
            for (int m = 0; m < 4; ++m) {
                const int row = u.pm * 256 + ai * 128 + wr * 64 + m * 16 + fr; const size_t off = (size_t)row * DM + col0;
                const float rs = rsqrtf(sv[ai][m] * (1.f / DM) + EPS);
#pragma unroll
                for (int bj = 0; bj < 2; ++bj)
#pragma unroll
                    for (int n = 0; n < 2; ++n) *(f32x4*)(out + off + bj * 128 + n * 4) = acc[ai][bj][m][n] * rs * gv[bj][n];
            }
    }
};
}

namespace att {
constexpr int NW = 8, QBLK = 32, KVBLK = 64, QB = NW * QBLK, D = 128;
constexpr int SHM_V = KVBLK * D * 2, SHM_K = KVBLK * D * 2;
constexpr int OFF_WSF = 2 * SHM_V + 2 * SHM_K, OFF_X = OFF_WSF + NW * 64 * 4, OFF_QXL = OFF_X + 2048, OFF_QL = OFF_QXL + 8192;
constexpr float SCALE = 0.08838834764831845f;
constexpr float THR = 8.f;
#define KSWZ(row, colB) ((row) * 256 + ((colB) ^ (((row) & 15) << 4)))
#define SBAR() __builtin_amdgcn_sched_barrier(0)
__device__ __forceinline__ int v_st(int k, int c) { const int kk = (k & ~0xC) | ((k & 4) << 1) | ((k & 8) >> 1); return ((kk >> 3) * 4 + (c >> 5)) * 512 + ((kk & 7) * 32 + (c & 31)) * 2; }
__device__ __forceinline__ int v_rd_base(int lane) { return ((lane & 3) << 3) | (((lane >> 2) & 3) << 6) | (((lane >> 4) & 1) << 5) | (((lane >> 5) & 1) << 8); }
constexpr int v_rd_off(int d0, int ks, int half) { return d0 * 512 + ks * 4096 + half * 2048; }
__device__ __forceinline__ int crow(int r, int hi) { return (r & 3) + 8 * (r >> 2) + 4 * hi; }
__device__ __forceinline__ bf16x8 load8(const bf16_t* p) { return *reinterpret_cast<const bf16x8*>(p); }
template <bool SM>
__device__ __forceinline__ void mask_tile(f32x16& p0, f32x16& p1, int dq) {
    const float NEG = SM ? -__builtin_inff() : 0.f;
#pragma unroll
    for (int r = 0; r < 16; ++r) {
        const int c = (r & 3) + 8 * (r >> 2);
        if (dq - c < 0) p0[r] = NEG;
        if (dq - c - 32 < 0) p1[r] = NEG;
    }
}
__device__ __forceinline__ void partialSM(f32x16& p0, f32x16& p1, float& m_reg, float& mn, float& alpha) {
    float pmax = p0[0]; for (int r = 1; r < 16; ++r) pmax = fmaxf(pmax, p0[r]); for (int r = 0; r < 16; ++r) pmax = fmaxf(pmax, p1[r]);
    { auto rr = __builtin_amdgcn_permlane32_swap(__float_as_uint(pmax), __float_as_uint(pmax), false, false);
      pmax = fmaxf(__uint_as_float(rr[0]), __uint_as_float(rr[1])); }
    constexpr float C2 = 1.4426950408889634f * SCALE;
    if (__builtin_expect(__all((pmax - m_reg) * SCALE <= THR), 1)) { mn = m_reg; alpha = 1.f; }
    else { mn = fmaxf(m_reg, pmax); alpha = __builtin_amdgcn_exp2f((m_reg - mn) * C2); m_reg = mn; }
    const float mnL = -mn * C2;
    for (int r = 0; r < 16; ++r) p0[r] = fmaf(p0[r], C2, mnL); for (int r = 0; r < 16; ++r) p1[r] = fmaf(p1[r], C2, mnL);
    for (int r = 0; r < 16; ++r) p0[r] = __builtin_amdgcn_exp2f(p0[r]);
}
template <bool SM>
__device__ __forceinline__ void finishSM(f32x16& p0, f32x16& p1, float alpha, float& l_reg, bf16x8& pa0, bf16x8& pa1, bf16x8& pa2, bf16x8& pa3) {
    if (SM) {
        for (int r = 0; r < 16; ++r) p1[r] = __builtin_amdgcn_exp2f(p1[r]);
        float ps = 0; for (int r = 0; r < 16; ++r) ps += p0[r]; for (int r = 0; r < 16; ++r) ps += p1[r];
        { auto rr = __builtin_amdgcn_permlane32_swap(__float_as_uint(ps), __float_as_uint(ps), false, false);
          ps = __uint_as_float(rr[0]) + __uint_as_float(rr[1]); }
        l_reg = l_reg * alpha + ps;
    }
#define PK4(P, B_, OUT) do { unsigned a0 = cvt_pk_bf16(P[B_+0], P[B_+1]), a1 = cvt_pk_bf16(P[B_+2], P[B_+3]);                          \
        unsigned b0 = cvt_pk_bf16(P[B_+4], P[B_+5]), b1 = cvt_pk_bf16(P[B_+6], P[B_+7]);                                             \
        auto r0 = __builtin_amdgcn_permlane32_swap(a0, b0, false, false); auto r1 = __builtin_amdgcn_permlane32_swap(a1, b1, false, false); \
        u32x4 w = {r0[0], r1[0], r0[1], r1[1]}; OUT = *reinterpret_cast<bf16x8*>(&w); } while (0)
    PK4(p0, 0, pa0); PK4(p0, 8, pa1); PK4(p1, 0, pa2); PK4(p1, 8, pa3);
#undef PK4
}
template <int KB, bool SM>
__device__ __forceinline__ void qkt(f32x16& p0, f32x16& p1, const char* lds, int r32, int hi, const bf16x8* qr, int qxa, const int* qlb) {
    p0 = f32x16{}; p1 = f32x16{};
    int kb[4];
#pragma unroll
    for (int dd = 0; dd < 4; ++dd) kb[dd] = 2 * SHM_V + KB * SHM_K + KSWZ(r32, (dd * 16 + hi * 8) * 2);
#pragma unroll
    for (int d0 = 0; d0 < 8; ++d0) { const char* a = lds + (kb[d0 & 3] ^ ((d0 >> 2) * 128));
        bf16x8 b0 = *reinterpret_cast<const bf16x8*>(a);
        bf16x8 b1 = *reinterpret_cast<const bf16x8*>(a + 32 * 256);
        const bf16x8 qf = SM ? *reinterpret_cast<const bf16x8*>(lds + (qlb[d0 & 3] ^ ((d0 >> 2) * 128))) : qr[d0];
        p0 = __builtin_amdgcn_mfma_f32_32x32x16_bf16(b0, qf, p0, 0, 0, 0);
        p1 = __builtin_amdgcn_mfma_f32_32x32x16_bf16(b1, qf, p1, 0, 0, 0); }
    if (SM) { const char* xb = lds + OFF_X + KB * 1024 + r32 * 16;
        bf16x8 x0 = *reinterpret_cast<const bf16x8*>(xb), x1 = *reinterpret_cast<const bf16x8*>(xb + 512); const bf16x8 qx = *reinterpret_cast<const bf16x8*>(lds + qxa);
        p0 = __builtin_amdgcn_mfma_f32_32x32x16_bf16(x0, qx, p0, 0, 0, 0);
        p1 = __builtin_amdgcn_mfma_f32_32x32x16_bf16(x1, qx, p1, 0, 0, 0); }
}
template <int VB>
__device__ __forceinline__ void pv_tile(f32x16* o, int vb0, bf16x8 pa0, bf16x8 pa1, bf16x8 pa2, bf16x8 pa3) {
#define TRRD(dst, off) asm volatile("ds_read_b64_tr_b16 %0, %1 offset:%2" : "=&v"(dst) : "v"(vb0), "i"(off) : "memory")
#define PV_D0(d0) do { s16x4 l0, l1, l2, l3, h0, h1, h2, h3; constexpr int b_ = VB * SHM_V + v_rd_off(d0, 0, 0); \
        TRRD(l0, b_); TRRD(h0, b_ + 2048); TRRD(l1, b_ + 4096); TRRD(h1, b_ + 6144); TRRD(l2, b_ + 8192); TRRD(h2, b_ + 10240); TRRD(l3, b_ + 12288); TRRD(h3, b_ + 14336); \
        asm volatile("s_waitcnt lgkmcnt(0)" ::: "memory"); SBAR();   \
        o[d0] = __builtin_amdgcn_mfma_f32_32x32x16_bf16(pa0, (bf16x8){l0[0], l0[1], l0[2], l0[3], h0[0], h0[1], h0[2], h0[3]}, o[d0], 0, 0, 0);   \
        o[d0] = __builtin_amdgcn_mfma_f32_32x32x16_bf16(pa1, (bf16x8){l1[0], l1[1], l1[2], l1[3], h1[0], h1[1], h1[2], h1[3]}, o[d0], 0, 0, 0);   \
        o[d0] = __builtin_amdgcn_mfma_f32_32x32x16_bf16(pa2, (bf16x8){l2[0], l2[1], l2[2], l2[3], h2[0], h2[1], h2[2], h2[3]}, o[d0], 0, 0, 0);   \
        o[d0] = __builtin_amdgcn_mfma_f32_32x32x16_bf16(pa3, (bf16x8){l3[0], l3[1], l3[2], l3[3], h3[0], h3[1], h3[2], h3[3]}, o[d0], 0, 0, 0); } while (0)
    PV_D0(0); PV_D0(1); PV_D0(2); PV_D0(3);
#undef PV_D0
#undef TRRD
}
struct BlockRef { unsigned Q, K, V, qxp, kxp, O, Gt; int P0, h; };
struct Seam { bf16x8 qr[8]; bf16x8 st_v0, st_v1, st_k0, st_k1; };
#define ROWB(p, k0, rr) (*(const bf16x8*)(wsb + (size_t)(p) + (size_t)((k0) + (rr)) * 256 + tko))
#define VMW() asm volatile("s_waitcnt vmcnt(0)" ::: "memory")
#define VMWN(n) asm volatile("s_waitcnt vmcnt(%0)" :: "i"(n) : "memory")
#define SLOAD_H(Kp, Vp, Xp, k0) do { S.st_v0 = ROWB(Vp, k0, 0); S.st_v1 = ROWB(Vp, k0, 32);              \
                         S.st_k0 = ROWB(Kp, k0, 0); S.st_k1 = ROWB(Kp, k0, 32); } while (0)
#define XDMA(Xp, k0, bf) do { if (SM && wid == 0) __builtin_amdgcn_global_load_lds((const unsigned*)(wsb + (size_t)(Xp) + (size_t)(k0) * 16 + txo), (LAS unsigned*)(ldsu + OFF_X + (bf) * 1024), 16, 0, 0); } while (0)
#define SWRITE_HK(bf) do { *(bf16x8*)(K_lds + (bf) * SHM_K + kws) = S.st_k0; *(bf16x8*)(K_lds + (bf) * SHM_K + kws + 32 * 256) = S.st_k1; } while (0)
#define SWRITE_HV(bf) do { *(bf16x8*)(V_lds + (bf) * SHM_V + vst0) = S.st_v0; *(bf16x8*)(V_lds + (bf) * SHM_V + vst1) = S.st_v1; } while (0)
#define SWRITE_H(bf) do { SWRITE_HV(bf); SWRITE_HK(bf); } while (0)
template <bool SM>
__device__ __forceinline__ void prime(const BlockRef& cur, char* lds, Seam& S, const char* wsb) {
    int tid = threadIdx.x; asm volatile("" : "+v"(tid));
    const int wid = __builtin_amdgcn_readfirstlane(tid >> 6), lane = tid & 63, r32 = lane & 31, hi = lane >> 5;
    const int sr = tid >> 4, sc = (tid & 15) * 8, kws = KSWZ(sr, sc * 2); char* K_lds = lds + 2 * SHM_V;
    const unsigned tko = (unsigned)(sr * D + sc) * 2u, txo = (unsigned)(tid & 63) * 16u, tqo = (unsigned)((wid * QBLK + r32) * D + hi * 8) * 2u, tqx = (unsigned)(wid * QBLK + r32) * 16u;
    for (int d0 = 0; d0 < 8; ++d0) S.qr[d0] = *(const bf16x8*)(wsb + (size_t)cur.Q + tqo + d0 * 32);
    const unsigned ldsu = (unsigned)(uintptr_t)lds;
    if (SM) {
#pragma unroll
        for (int d0 = 0; d0 < 8; ++d0) *(bf16x8*)(lds + OFF_QL + wid * 8192 + r32 * 256 + ((((d0 * 2) | hi) ^ (r32 & 15)) * 16)) = S.qr[d0]; }
    if (SM) { const bf16x8 qv = *(const bf16x8*)(wsb + (size_t)cur.qxp + tqx); *(bf16x8*)(lds + OFF_QXL + wid * 1024 + (hi ? 512 : r32 * 16)) = hi ? (bf16x8){0, 0, 0, 0, 0, 0, 0, 0} : qv; }
    SLOAD_H(cur.K, cur.V, cur.kxp, 0); XDMA(cur.kxp, 0, 0); VMW(); SWRITE_HK(0);
    __syncthreads();
}
template <bool SM>
__device__ __forceinline__ void block(const BlockRef& cur, const BlockRef& nxt, char* lds, Seam& S, const char* wsb, const float* ret_gain) {
    int tid = threadIdx.x; asm volatile("" : "+v"(tid));
    const int wid = __builtin_amdgcn_readfirstlane(tid >> 6), lane = tid & 63, r32 = lane & 31, hi = lane >> 5;
    const int NT = (cur.P0 + QB - 1) / KVBLK + 1;
    const int qlo = cur.P0 + wid * QBLK, qm = qlo + r32 - 4 * hi;
    char* V_lds = lds; char* K_lds = lds + 2 * SHM_V;
    float* ws = (float*)(lds + OFF_WSF) + wid * 64; float* li_l = ws, * al_l = ws + 32;
    float m_reg = -1e30f, l_reg = 0; f32x16 o[4] = {};
    const int sr = tid >> 4, sc = (tid & 15) * 8, vst0 = v_st(sr, sc), vst1 = v_st(32 + sr, sc), kws = KSWZ(sr, sc * 2);
    const unsigned tko = (unsigned)(sr * D + sc) * 2u, txo = (unsigned)(tid & 63) * 16u, ldsu = (unsigned)(uintptr_t)lds;
    const int qxa = OFF_QXL + wid * 1024 + (hi ? 512 : r32 * 16);
    int qlb[4];
#pragma unroll
    for (int dd = 0; dd < 4; ++dd) qlb[dd] = OFF_QL + wid * 8192 + r32 * 256 + ((((dd * 2) | hi) ^ (r32 & 15)) * 16);
    const int vb0 = (int)(uintptr_t)V_lds + v_rd_base(lane);
    const unsigned Kh = cur.K, Vh = cur.V, Xh = cur.kxp;
#define RESC(a) do { if (SM) { if (__any((a) < 1.f)) { if (hi == 0) al_l[r32] = (a); asm volatile("s_waitcnt lgkmcnt(0)" ::: "memory");              \
                     for (int d_ = 0; d_ < 4; ++d_) for (int r = 0; r < 16; ++r) o[d_][r] *= al_l[crow(r, hi)]; } } } while (0)
#define KBASE(t) ((t) * KVBLK)
#define MASKT(P0_, P1_, t) do { const int kb_ = KBASE(t); if (kb_ + KVBLK - 1 > qlo) mask_tile<SM>(P0_, P1_, qm - kb_); } while (0)
#define PSM(P0_, P1_, mn_, al_) do { if (SM) partialSM(P0_, P1_, m_reg, mn_, al_); } while (0)
    constexpr int NQL = 8;
#define SEAM_K0() do { VMWN(NQL); SWRITE_HK(0); SBAR(); } while (0)
    f32x16 pA0, pA1, pB0, pB1; float mnA = 0, mnB = 0, alA = 1.f, alB = 1.f; bf16x8 pa0, pa1, pa2, pa3;
    SWRITE_HV(0); SBAR();
    if (NT > 1) { SLOAD_H(Kh, Vh, Xh, KBASE(1)); XDMA(Xh, KBASE(1), 1); }
    SBAR(); qkt<0, SM>(pA0, pA1, lds, r32, hi, S.qr, qxa, qlb);
    MASKT(pA0, pA1, 0); PSM(pA0, pA1, mnA, alA);
    if (NT > 1) { VMW(); SWRITE_H(1); }
    __syncthreads();
#define HALF_STEP(PX0, PX1, mnX, alX, PY0, PY1, alY, t, KB, VB, SB) do {                                                      \
        SBAR(); qkt<KB, SM>(PX0, PX1, lds, r32, hi, S.qr, qxa, qlb);                                             \
        finishSM<SM>(PY0, PY1, alY, l_reg, pa0, pa1, pa2, pa3); SBAR();                                                           \
        if ((t) + 1 < NT) { SLOAD_H(Kh, Vh, Xh, KBASE((t) + 1)); XDMA(Xh, KBASE((t) + 1), SB); SBAR(); }                                               \
        pv_tile<VB>(o, vb0, pa0, pa1, pa2, pa3); MASKT(PX0, PX1, (t)); PSM(PX0, PX1, mnX, alX);                                        \
        __syncthreads();                                                                                                      \
        if ((t) + 1 < NT) { VMW(); SWRITE_H(SB); }                                                                          \
        RESC(alX); __syncthreads(); } while (0)
    for (int t = 1; t + 1 < NT; t += 2) {
        HALF_STEP(pB0, pB1, mnB, alB, pA0, pA1, alA, t, 1, 0, 0);
        HALF_STEP(pA0, pA1, mnA, alA, pB0, pB1, alB, t + 1, 0, 1, 1);
    }
    const bool even = (NT & 1) == 0;
    if (even) { SBAR(); qkt<1, SM>(pB0, pB1, lds, r32, hi, S.qr, qxa, qlb); SBAR(); }
    SLOAD_H(nxt.K, nxt.V, nxt.kxp, 0); XDMA(nxt.kxp, 0, 0); SBAR();
    { unsigned tqo = (unsigned)((wid * QBLK + r32) * D + hi * 8) * 2u; asm volatile("" : "+v"(tqo));
#pragma unroll
    for (int d0 = 0; d0 < 8; ++d0) S.qr[d0] = *(const bf16x8*)(wsb + (size_t)nxt.Q + tqo + d0 * 32);
    }
    SBAR();
    finishSM<SM>(pA0, pA1, alA, l_reg, pa0, pa1, pa2, pa3); SBAR();
    pv_tile<0>(o, vb0, pa0, pa1, pa2, pa3);
    if (even) { MASKT(pB0, pB1, NT - 1); PSM(pB0, pB1, mnB, alB); __syncthreads(); RESC(alB);
        finishSM<SM>(pB0, pB1, alB, l_reg, pa0, pa1, pa2, pa3); SBAR(); pv_tile<1>(o, vb0, pa0, pa1, pa2, pa3); }
    SBAR(); SEAM_K0();
    unsigned obase = (unsigned)((wid * QBLK + (lane >> 4)) * DM + (lane & 15) * 8) * 2u; asm volatile("" : "+v"(obase));
    unsigned sbase = (unsigned)(4 * hi * 128 + r32); asm volatile("" : "+v"(sbase));
    unsigned lbase = (unsigned)lane * 16u; asm volatile("" : "+v"(lbase));
    unsigned short* const stg = (unsigned short*)(lds + OFF_QL + wid * 8192);
    char* const Ob = (char*)wsb + (size_t)cur.O;
    if (SM) {
        if (hi == 0) li_l[r32] = l_reg; asm volatile("s_waitcnt lgkmcnt(0)" ::: "memory");
#pragma unroll
        for (int r = 0; r < 16; ++r) { const int c0 = (r & 3) + 8 * (r >> 2); const float rl = __builtin_amdgcn_rcpf(li_l[c0 + 4 * hi]);
#pragma unroll
            for (int d0 = 0; d0 < 4; ++d0) { const float v = o[d0][r] * rl; stg[sbase + c0 * 128 + d0 * 32] = (unsigned short)cvt_pk_bf16(v, 0.f); } }
    } else {
        unsigned gbase = (unsigned)((wid * QBLK + 4 * hi) * 1024 + r32) * 2u; asm volatile("" : "+v"(gbase));
        const char* const Gb = wsb + (size_t)cur.Gt;
        float gn[4];
#pragma unroll
        for (int d0 = 0; d0 < 4; ++d0) gn[d0] = ret_gain[cur.h * 128 + d0 * 32 + r32];
        float gv[16][4];
#pragma unroll
        for (int r = 0; r < 16; ++r) { const int c0 = (r & 3) + 8 * (r >> 2);
#pragma unroll
            for (int d0 = 0; d0 < 4; ++d0) gv[r][d0] = bf2f(*(const bf16_t*)(Gb + gbase + (unsigned)(c0 * 1024 + d0 * 32) * 2u)); }
#pragma unroll
        for (int r = 0; r < 16; ++r) { const int c0 = (r & 3) + 8 * (r >> 2);
            float s = (o[0][r] + o[1][r]) + (o[2][r] + o[3][r]);
            float q = (o[0][r] * o[0][r] + o[1][r] * o[1][r]) + (o[2][r] * o[2][r] + o[3][r] * o[3][r]);
#pragma unroll
            for (int x = 1; x < 32; x <<= 1) { s += __shfl_xor(s, x); q += __shfl_xor(q, x); }
            const float mu = s * (1.f / 128.f), var = fmaxf(q * (1.f / 128.f) - mu * mu, 0.f), rs = rsqrtf(var + EPS);
#pragma unroll
            for (int d0 = 0; d0 < 4; ++d0) { const float g = gv[r][d0];
                const float v = (o[d0][r] - mu) * rs * gn[d0] * g; stg[sbase + c0 * 128 + d0 * 32] = (unsigned short)cvt_pk_bf16(v, 0.f); } }
    }
    asm volatile("s_waitcnt lgkmcnt(0)" ::: "memory");
#pragma unroll
    for (int i = 0; i < 8; ++i) { const u32x4 w = *(const u32x4*)((const char*)stg + lbase + i * 1024); *(u32x4*)(Ob + obase + (unsigned)(i * 4 * DM) * 2u) = w; }
    asm volatile("s_waitcnt lgkmcnt(0)" ::: "memory");
    if (SM) {
#pragma unroll
        for (int d0 = 0; d0 < 8; ++d0) *(bf16x8*)(lds + (qlb[d0 & 3] ^ ((d0 >> 2) * 128))) = S.qr[d0]; }
    if (SM) { unsigned tqx = (unsigned)(wid * QBLK + r32) * 16u; asm volatile("" : "+v"(tqx));
        if (hi == 0) *(bf16x8*)(lds + OFF_QXL + wid * 512 + tqx) = *(const bf16x8*)(wsb + (size_t)nxt.qxp + tqx); }
    __syncthreads();
#undef RESC
#undef KBASE
#undef MASKT
#undef PSM
#undef SEAM_K0
#undef HALF_STEP
}
#undef ROWB
#undef VMW
#undef VMWN
#undef SLOAD_H
#undef XDMA
#undef SWRITE_HK
#undef SWRITE_HV
#undef SWRITE_H

template <bool SM, class MK>
__device__ __forceinline__ void run(int item, int nitems, int istride, char* lds, const char* wsb, const float* ret_gain, const MK& mk) {
    if (item >= nitems) return;
    int pass = 0; Seam S; BlockRef cur = mk(item, 0);
    prime<SM>(cur, lds, S, wsb);
    for (;;) {
        const bool more_pass = pass == 0, more_item = item + istride < nitems, last = !more_pass && !more_item;
        int itn = item, psn = pass + 1; if (!more_pass) { psn = 0; itn = more_item ? item + istride : item; }
        const BlockRef nxt = last ? cur : mk(itn, psn);
        block<SM>(cur, nxt, lds, S, wsb, ret_gain);
        if (last) break;
        cur = nxt; item = itn; pass = psn;
    }
}
}

#ifndef PHMASK
#define PHMASK 0xff
#endif
#define PH(n) ((PHMASK >> (n)) & 1)
#ifndef DUPMASK
#define DUPMASK 0
#endif
#define DUP(n) (((DUPMASK >> (n)) & 1) ? 2 : 1)
struct Args {
    const float *x, *meta, *g1, *w_in, *b_forget, *ret_gain, *w_out, *g2, *w_up, *conv_w, *conv_b, *w_down, *gf;
    float* out; unsigned char* ws;
};

__device__ __forceinline__ float wave_sum(float v) {
#pragma unroll
    for (int o = 1; o < 64; o <<= 1) v += __shfl_xor(v, o);
    return v;
}
struct TrItem { const float* W; bf16_t* WT; const float* kscale; int ldw, K, k0, n0, mode; };
__device__ __forceinline__ TrItem tr_decode(int it, const float* w_in, const float* w_out, const float* w_up, const float* w_down, const float* g2, unsigned char* ws, const float* g1) {
    constexpr int I_IN = (DM / 64) * (NPROJ / 64), I_OUT = (DM / 64) * (DM / 64), I_UP = (DM / 64) * (NUP / 64);
    TrItem t; int r = it;
    if (r < I_IN) { const int nb = NPROJ / 64; t.W = w_in; t.WT = (bf16_t*)(ws + OFF_WTIN); t.kscale = g1; t.ldw = INDIM; t.K = DM; t.k0 = 64 * (r / nb); t.n0 = 64 * (r % nb); t.mode = t.n0 < 2048 ? 1 : 0; return t; } r -= I_IN;
    if (r < I_OUT) { const int nb = DM / 64; t.W = w_out; t.WT = (bf16_t*)(ws + OFF_WTOUT); t.kscale = nullptr; t.ldw = DM; t.K = DM; t.k0 = 64 * (r / nb); t.n0 = 64 * (r % nb); t.mode = 0; return t; } r -= I_OUT;
    if (r < I_UP) { const int nb = NUP / 64; t.W = w_up; t.WT = (bf16_t*)(ws + OFF_WTUP); t.kscale = g2; t.ldw = NUP; t.K = DM; t.k0 = 64 * (r / nb); t.n0 = 64 * (r % nb); t.mode = 2; return t; } r -= I_UP;
    { const int nb = DM / 64; t.W = w_down; t.WT = (bf16_t*)(ws + OFF_WTDN); t.kscale = nullptr; t.ldw = DM; t.K = DFF; t.k0 = 64 * (r / nb); t.n0 = 64 * (r % nb); t.mode = 0; return t; }
}
__device__ __forceinline__ void tr_load(const TrItem& t, f32x4 (&v)[16], int lane) {
    const float* p = t.W + (size_t)(t.k0 + (lane >> 4)) * t.ldw + t.n0 + 4 * (lane & 15);
#pragma unroll
    for (int i = 0; i < 16; ++i) v[i] = __builtin_nontemporal_load((const f32x4*)(p + (size_t)(4 * i) * t.ldw));
}
__device__ __forceinline__ void tr_store(const TrItem& t, const f32x4 (&v)[16], LAS float* scr, int lane) {
#pragma unroll
    for (int i = 0; i < 16; ++i) { LAS float* d = scr + (4 * i + (lane >> 4)) * 65 + 4 * (lane & 15); d[0] = v[i][0]; d[1] = v[i][1]; d[2] = v[i][2]; d[3] = v[i][3]; }
    asm volatile("s_waitcnt lgkmcnt(0)" ::: "memory");
    const int c = lane & 7;
    float ks[8];
#pragma unroll
    for (int j = 0; j < 8; ++j) ks[j] = t.kscale ? t.kscale[t.k0 + 8 * c + j] : 1.f;
#pragma unroll
    for (int q = 0; q < 8; ++q) { const int n = q * 8 + (lane >> 3); const LAS float* s = scr + (8 * c) * 65 + n;
        u32x4 o; o.x = pk2(s[0 * 65] * ks[0], s[1 * 65] * ks[1]); o.y = pk2(s[2 * 65] * ks[2], s[3 * 65] * ks[3]); o.z = pk2(s[4 * 65] * ks[4], s[5 * 65] * ks[5]); o.w = pk2(s[6 * 65] * ks[6], s[7 * 65] * ks[7]);
        int dn = t.n0 + n;
        if (t.mode == 2) { const int ch = dn < DFF ? dn : dn - DFF; dn = 256 * (ch >> 7) + (dn < DFF ? 0 : 128) + (ch & 127); }
        if (t.mode == 1) { const int d = dn & 127; const int p = (d < 64) ? (8 * (d >> 2) + (d & 3)) : (8 * ((d - 64) >> 2) + 4 + (d & 3)); dn = (dn & ~127) + p; }
        *(u32x4*)(t.WT + (size_t)dn * t.K + t.k0 + 8 * c) = o; }
    asm volatile("s_waitcnt lgkmcnt(0)" ::: "memory");
}

__device__ __forceinline__ void tr_run(int it, int it_end, int stride, LAS float* scr, int lane, const float* w_in, const float* w_out, const float* w_up, const float* w_down, const float* g2, unsigned char* ws, const float* g1) {
    f32x4 va[16], vb[16];
    if (it >= it_end) return;
    TrItem ta = tr_decode(it, w_in, w_out, w_up, w_down, g2, ws, g1); tr_load(ta, va, lane);
    for (;;) {
        const int itb = it + stride; TrItem tb = ta; const bool hb = itb < it_end;
        if (hb) { tb = tr_decode(itb, w_in, w_out, w_up, w_down, g2, ws, g1); tr_load(tb, vb, lane); }
        tr_store(ta, va, scr, lane);
        if (!hb) break;
        const int itc = itb + stride; const bool hc = itc < it_end;
        if (hc) { ta = tr_decode(itc, w_in, w_out, w_up, w_down, g2, ws, g1); tr_load(ta, va, lane); }
        tr_store(tb, vb, scr, lane);
        if (!hc) break;
        it = itc;
    }
}
constexpr int TR_N0 = (DM / 64) * (NPROJ / 64);
constexpr int TR_N1 = TR_N0 + (DM / 64) * (DM / 64) + (DM / 64) * (NUP / 64);
constexpr int TR_NIT = TR_N1 + (DFF / 64) * (DM / 64);

#define ss2 ((float*)(ws + OFF_SS2))
#define ss3 ((float*)(ws + OFF_SS3))
#define logf_ ((float*)(ws + OFF_LOGF))
#define cosT ((float*)(ws + OFF_COS))
#define sinT ((float*)(ws + OFF_SIN))
#define dec ((float*)(ws + OFF_DEC))
#define deci ((float*)(ws + OFF_DECI))
#define QX ((bf16_t*)(ws + OFF_QX))
#define KX ((bf16_t*)(ws + OFF_KX))
#define QM ((bf16_t*)(ws + OFF_QM))
#define WtIn ((bf16_t*)(ws + OFF_WTIN))
#define WtOut ((bf16_t*)(ws + OFF_WTOUT))
#define WtUp ((bf16_t*)(ws + OFF_WTUP))
#define WtDn ((bf16_t*)(ws + OFF_WTDN))
#define A1 ((bf16_t*)(ws + OFF_A1))
#define A2 ((bf16_t*)(ws + OFF_A2))
#define ACT ((bf16_t*)(ws + OFF_ACT))
#define SIDE ((bf16_t*)(ws + OFF_SIDE))
#define RQ ((bf16_t*)(ws + OFF_RQ))
#define RK ((bf16_t*)(ws + OFF_RK))
#define RV ((bf16_t*)(ws + OFF_RV))
#define FQ ((bf16_t*)(ws + OFF_FQ))
#define FK ((bf16_t*)(ws + OFF_FK))
#define FV ((bf16_t*)(ws + OFF_FV))
#define GT ((bf16_t*)(ws + OFF_G))
#define MIX ((bf16_t*)(ws + OFF_MIX))

#define XB_TMO      128
#define XB_XCNT(j)  (256  + 64 * (j))
#define XB_XSUB(j)  (1280 + 64 * (j))
#define XB_XGEN(j)  (2304 + 64 * (j))
#define XB_TOP      3328
#define XB_TOPGEN   3392
#define XCD_BAR_WORDS 3456
#define XB_SPIN_CAP (1u << 22)
__device__ __forceinline__ unsigned xb_ld(unsigned* p)              { return __hip_atomic_load(p, __ATOMIC_RELAXED, __HIP_MEMORY_SCOPE_AGENT); }
__device__ __forceinline__ unsigned xb_add(unsigned* p, unsigned v) { return __hip_atomic_fetch_add(p, v, __ATOMIC_RELAXED, __HIP_MEMORY_SCOPE_AGENT); }
__device__ __forceinline__ unsigned xb_xcc_id() { return (unsigned)__builtin_amdgcn_s_getreg((3 << 11) | 20) & 0xFu; }
#define XB_SPIN(cond, bar) do { unsigned _sp = 0; while (cond) { __builtin_amdgcn_s_sleep(1); \
    if ((++_sp & 255u) == 0u) { if (xb_ld(&(bar)[XB_TMO])) break; if (_sp > XB_SPIN_CAP) { atomicAdd(&(bar)[XB_TMO], 1u); break; } } } } while (0)
struct XcdBarrier { unsigned* bar; unsigned x; volatile LAS unsigned* st; };
__device__ __forceinline__ XcdBarrier xcd_barrier_post(unsigned* bar, volatile LAS unsigned* st) {
    XcdBarrier b; b.bar = bar; b.x = xb_xcc_id(); b.st = st;
    if (threadIdx.x == 0) (void)xb_add(&bar[XB_XCNT(b.x)], 1u);
    return b;
}
__device__ __forceinline__ void xcd_barrier_complete(unsigned* bar, unsigned x, unsigned& nloc, unsigned& nx) {
    const unsigned G = gridDim.x * gridDim.y * gridDim.z;
    unsigned sum, cnt, mine, sp = 0u;
    for (;;) {
        sum = 0u; cnt = 0u; mine = 0u;
#pragma unroll
        for (unsigned j = 0; j < 16; ++j) { const unsigned c = xb_ld(&bar[XB_XCNT(j)]); sum += c; cnt += (c > 0u) ? 1u : 0u; mine = (j == x) ? c : mine; }
        if (sum == G) break;
        __builtin_amdgcn_s_sleep(1);
        if ((++sp & 255u) == 0u) { if (xb_ld(&bar[XB_TMO])) break; if (sp > XB_SPIN_CAP) { atomicAdd(&bar[XB_TMO], 1u); break; } }
    }
    nloc = mine > 0u ? mine : 1u; nx = cnt > 0u ? cnt : 1u;
}
__device__ __forceinline__ void xcd_barrier(const XcdBarrier& b) {
    asm volatile("s_waitcnt vmcnt(0)" ::: "memory");
    __syncthreads();
    if (threadIdx.x == 0) {
        unsigned* bar = b.bar;
        __builtin_amdgcn_s_waitcnt(0);
        unsigned nloc = b.st[0], nx = b.st[1];
        if (nloc == 0u) { xcd_barrier_complete(bar, b.x, nloc, nx); b.st[0] = nloc; b.st[1] = nx; }
        const unsigned old = xb_add(&bar[XB_XSUB(b.x)], 1u);
        const unsigned gen = old / nloc;
        if (old + 1u == (gen + 1u) * nloc) {
            __builtin_amdgcn_fence(__ATOMIC_RELEASE, "agent");
            asm volatile("s_waitcnt vmcnt(0)" ::: "memory");
            const unsigned og = xb_add(&bar[XB_TOP], 1u);
            const unsigned tg = og / nx;
            if (og + 1u == (tg + 1u) * nx) xb_add(&bar[XB_TOPGEN], 1u);
            else XB_SPIN(xb_ld(&bar[XB_TOPGEN]) == tg, bar);
            __builtin_amdgcn_fence(__ATOMIC_ACQUIRE, "agent");
            xb_add(&bar[XB_XGEN(b.x)], 1u);
            asm volatile("s_waitcnt vmcnt(0)" ::: "memory");
        } else {
            XB_SPIN(xb_ld(&bar[XB_XGEN(b.x)]) == gen, bar);
            __builtin_amdgcn_fence(__ATOMIC_ACQUIRE, "agent");
            asm volatile("s_waitcnt vmcnt(0)" ::: "memory");
        }
    }
    __syncthreads();
}

__device__ __forceinline__ att::BlockRef mk_block_ref(int it, int ps, bool fox) {
    att::BlockRef r; const int bh = it >> 2, y = it & 3, qb = ps ? 7 - y : y, b = bh >> 3, h = bh & 7;
    r.Q = (unsigned)((fox ? OFF_FQ : OFF_RQ) + ((size_t)bh * SEQ + qb * 256) * 256);
    r.K = (unsigned)((fox ? OFF_FK : OFF_RK) + (size_t)bh * KVP * 256); r.V = (unsigned)((fox ? OFF_FV : OFF_RV) + (size_t)bh * KVP * 256);
    r.P0 = NMETA + qb * 256; r.qxp = (unsigned)(OFF_QX + ((size_t)bh * KVP + r.P0) * 16); r.kxp = (unsigned)(OFF_KX + (size_t)bh * KVP * 16);
    const size_t trow = (size_t)b * SEQ + qb * 256; r.O = (unsigned)(OFF_MIX + (trow * DM + (fox ? 1024 : 0) + h * 128) * 2);
    r.Gt = (unsigned)(OFF_G + (trow * 1024 + h * 128) * 2); r.h = h; return r;
}

__global__ void __launch_bounds__(512, 2) mk_fwd(Args a) {
    extern __shared__ __attribute__((aligned(16))) unsigned char lds[];
    cg::grid_group grid = cg::this_grid();
    LAS unsigned char* L = (LAS unsigned char*)lds;
    const int G = gridDim.x, bx = blockIdx.x;
    const int NGW = G * 8, NGT = G * 512;
#define PHASE_TID() int tid = threadIdx.x; asm volatile("" : "+v"(tid)); const int lane = tid & 63, wave = __builtin_amdgcn_readfirstlane(tid >> 6); const int gw = bx * 8 + wave, gt = bx * 512 + tid; (void)lane; (void)gw; (void)gt;
    unsigned char* ws = a.ws;
    volatile LAS unsigned* bst = (volatile LAS unsigned*)(L + LDS_BYTES - 16);
    if (threadIdx.x == 0) { bst[0] = 0u; bst[1] = 0u; }
    __syncthreads();
    const XcdBarrier xbar = xcd_barrier_post((unsigned*)(ws + OFF_H1M), bst);
    if (a.ws == nullptr) grid.sync();


#if PH(0)
    for (int rep_ = 0; rep_ < DUP(0); ++rep_) { PHASE_TID(); if (rep_) __syncthreads();
    {
        LAS float* wf = (LAS float*)(L + 73728);
#pragma unroll
        for (int i = 0; i < 4; ++i) { const int k = tid + 512 * i; const f32x4 lo = *(const f32x4*)(a.w_in + (size_t)k * INDIM + NPROJ), hi4 = *(const f32x4*)(a.w_in + (size_t)k * INDIM + NPROJ + 4);
#pragma unroll
            for (int h = 0; h < 4; ++h) { wf[h * DM + k] = lo[h]; wf[(4 + h) * DM + k] = hi4[h]; } }
        __syncthreads();
        f32x4 vn[8];
        if (gw < MREAL + NMETA) { const float* xr = gw < MREAL ? a.x + (size_t)gw * DM : a.meta + (size_t)(gw - MREAL) * DM;
#pragma unroll
            for (int j = 0; j < 8; ++j) vn[j] = __builtin_nontemporal_load((const f32x4*)xr + lane + 64 * j); }
        for (int row = gw; row < MREAL + NMETA; row += NGW) {
            f32x4 v[8]; float s = 0.f;
#pragma unroll
            for (int j = 0; j < 8; ++j) { v[j] = vn[j]; s += (v[j][0] * v[j][0] + v[j][1] * v[j][1]) + (v[j][2] * v[j][2] + v[j][3] * v[j][3]); }
            { const int rn = row + NGW; if (rn < MREAL + NMETA) { const float* xr = rn < MREAL ? a.x + (size_t)rn * DM : a.meta + (size_t)(rn - MREAL) * DM;
#pragma unroll
                for (int j = 0; j < 8; ++j) vn[j] = __builtin_nontemporal_load((const f32x4*)xr + lane + 64 * j); } }
            const float rstd = rsqrtf(wave_sum(s) * (1.f / DM) + EPS);
            if (lane == 0 && row < MREAL) ((float*)(ws + OFF_IRS))[row] = 1.f / rstd;
            float fa[8] = {0, 0, 0, 0, 0, 0, 0, 0};
#pragma unroll
            for (int j = 0; j < 8; ++j) { const f32x4 gg = ((const f32x4*)a.g1)[lane + 64 * j]; v[j] = v[j] * rstd;
                u32x2 w; w.x = cvt_pk_bf16(v[j][0], v[j][1]); w.y = cvt_pk_bf16(v[j][2], v[j][3]);
                ((u32x2*)(A1 + (size_t)row * DM))[lane + 64 * j] = w;
                v[j] = v[j] * gg;
#pragma unroll
                for (int h = 0; h < 8; ++h) { const f32x4 wv = *(const LAS f32x4*)(wf + h * DM + 4 * (lane + 64 * j)); fa[h] += (v[j][0] * wv[0] + v[j][1] * wv[1]) + (v[j][2] * wv[2] + v[j][3] * wv[3]); } }
#pragma unroll
            for (int h = 0; h < 8; ++h) fa[h] = wave_sum(fa[h]);
            if (lane < 8) { float f = fa[0];
#pragma unroll
                for (int h = 1; h < 8; ++h) f = (lane == h) ? fa[h] : f;
                const float z = f + a.b_forget[lane];
                logf_[row * 8 + lane] = fminf(z, 0.f) - log1pf(__expf(-fabsf(z))); }
        }
        __syncthreads();
        tr_run(gw, TR_N0, NGW, (LAS float*)(L + wave * 16640), lane, a.w_in, a.w_out, a.w_up, a.w_down, a.g2, ws, a.g1);
        for (int i = gt; i < LTOT * 64; i += NGT) { const int pos = i >> 6, f = i & 63;
            const float inv = exp2f(-(float)f * (13.287712379549449f / 64.f));
            float sn, cs; sincosf((float)pos * inv, &sn, &cs); cosT[i] = cs; sinT[i] = sn; }
        for (int i = gt; i < NH * LTOT; i += NGT) { const int h = i / LTOT, pos = i - h * LTOT;
            const float lg = log1pf(-exp2f(-5.f - (float)h));
            dec[i] = expf(lg * (float)pos); deci[i] = expf(-lg * (float)pos) * 0.08838834764831845f; }
        for (int i = gt; i < MPAD; i += NGT) ss2[i] = 0.f;
        for (int i = gt; i < MREAL; i += NGT) ss3[i] = 0.f;
        for (int i = gt; i < (MPAD - MREAL - NMETA) * DM / 8; i += NGT) { ((u32x4*)(A1 + (size_t)(MREAL + NMETA) * DM))[i] = (u32x4){0, 0, 0, 0}; ((u32x4*)(A2 + (size_t)(MREAL + NMETA) * DM))[i] = (u32x4){0, 0, 0, 0}; }
        for (int i = gt; i < 32 * 48 * 16; i += NGT) { const int bh = i / (48 * 16), r = i - bh * (48 * 16); const size_t o = ((size_t)bh * KVP + LTOT) * 128 + (size_t)r * 8;
            *(u32x4*)(RK + o) = (u32x4){0, 0, 0, 0}; *(u32x4*)(RV + o) = (u32x4){0, 0, 0, 0}; *(u32x4*)(FK + o) = (u32x4){0, 0, 0, 0}; *(u32x4*)(FV + o) = (u32x4){0, 0, 0, 0}; }
    }
    }
#endif
    xcd_barrier(xbar);

#if PH(1)
    for (int rep_ = 0; rep_ < DUP(1); ++rep_) { PHASE_TID(); if (rep_) __syncthreads();
    if (bx >= G - 32) {
        const int bh = bx - (G - 32), b = bh >> 3, h = bh & 7;
        LAS float* sc = (LAS float*)L;
        float v[5]; float run = 0.f;
#pragma unroll
        for (int j = 0; j < 5; ++j) { const int p = tid * 5 + j; float lf = 0.f;
            if (p < LTOT) { const int row = p < NMETA ? MREAL + p : b * SEQ + (p - NMETA); lf = logf_[row * 8 + h]; }
            run += lf; v[j] = run; }
        float incl = run;
#pragma unroll
        for (int o = 1; o < 64; o <<= 1) { const float t = __shfl_up(incl, o); if (lane >= o) incl += t; }
        if (lane == 63) sc[wave] = incl;
        __syncthreads();
        float base = incl - run;
        for (int w = 0; w < wave; ++w) base += sc[w];
#pragma unroll
        for (int j = 0; j < 5; ++j) { const int p = tid * 5 + j;
            if (p < KVP) { u32x4 qv = {0, 0, 0, 0}, kv = {0, 0, 0, 0};
                if (p < LTOT) { const float g = (base + v[j]) * 11.313708498984761f;
                    const unsigned g1 = f2bf(g); const float r1 = g - bf2f(g1); const unsigned g2 = f2bf(r1); const float r2 = r1 - bf2f(g2); const unsigned g3 = f2bf(r2);
                    qv = (u32x4){0x3F803F80u, 0x3F80u | (g1 << 16), g2 | (g3 << 16), 0u};
                    kv = (u32x4){(g1 ^ 0x8000u) | ((g2 ^ 0x8000u) << 16), (g3 ^ 0x8000u) | (0x3F80u << 16), 0x3F803F80u, 0u}; }
                *(u32x4*)(QX + ((size_t)bh * KVP + p) * 8) = qv; *(u32x4*)(KX + ((size_t)bh * KVP + p) * 8) = kv; } }
        __syncthreads();
    }
    {
        pg8::Gemm g{A1, WtIn, MPAD, NPROJ, DM}; pg8::StaticOrder S; S.init(MPAD, NPROJ, G, bx);
        pg8::EpiProj E{ws};
        pg8::gemm_phase<pg8::EpiProj>(L, g, S, E);
    }
    { constexpr int NU1 = (MPAD / 256) * (NPROJ / 256); const int first_idle = NU1 - 3 * G;
      if (first_idle > 0 && first_idle < G) { if (bx >= first_idle) tr_run(TR_N0 + (bx - first_idle) * 8 + wave, TR_N1, (G - first_idle) * 8, (LAS float*)(L + wave * 16640), lane, a.w_in, a.w_out, a.w_up, a.w_down, a.g2, ws, a.g1); }
      else tr_run(TR_N0 + gw, TR_N1, NGW, (LAS float*)(L + wave * 16640), lane, a.w_in, a.w_out, a.w_up, a.w_down, a.g2, ws, a.g1); }
    }
#endif
    xcd_barrier(xbar);

#if PH(2)
    for (int rep_ = 0; rep_ < DUP(2); ++rep_) { PHASE_TID(); if (rep_) __syncthreads();
#ifndef NO_META
    if (bx >= G - 2) {
        const int h = tid >> 6, i = (tid >> 2) & 15, dq = tid & 3;
        LAS float* cumL = (LAS float*)(L + 140000);
        LAS float* scL = (LAS float*)(L + 98304);
        if (tid < 8) { float c = 0.f; for (int j = 0; j < 16; ++j) { c += logf_[(MREAL + j) * 8 + tid]; cumL[tid * 16 + j] = c; } }
        __syncthreads();
        const float cumi = cumL[h * 16 + i];
        { const int mode = bx == G - 1 ? 1 : 0;
            { const bf16_t* Kg = mode ? FK : RK; const bf16_t* Vg = mode ? FV : RV;
#pragma unroll
              for (int c4 = 0; c4 < 4; ++c4) { const int c = tid + 512 * c4, hh = c >> 8, w = c & 255;
                  const u32x4 kq = *(const u32x4*)(Kg + (size_t)hh * KVP * 128 + w * 8), vq = *(const u32x4*)(Vg + (size_t)hh * KVP * 128 + w * 8);
                  *(LAS u32x4*)(L + c * 16) = kq; *(LAS u32x4*)(L + 32768 + c * 16) = vq; } }
            __syncthreads();
            const bf16_t* q = QM + (size_t)((mode * 8 + h) * 16 + i) * 128 + dq * 32;
            const LAS unsigned char* Kp = L + h * 4096 + dq * 64; const LAS unsigned char* Vp = L + 32768 + h * 4096 + dq * 64;
            u32x4 qv[4];
#pragma unroll
            for (int d8 = 0; d8 < 4; ++d8) qv[d8] = *(const u32x4*)(q + d8 * 8);
            float mx = -1e30f;
#pragma unroll 1
            for (int j = 0; j < 16; ++j) { float sdot = 0.f;
#pragma unroll
                for (int d8 = 0; d8 < 4; ++d8) { const u32x4 kv = *(const LAS u32x4*)(Kp + j * 256 + d8 * 16);
#pragma unroll
                    for (int e = 0; e < 4; ++e) sdot += bf2f(qv[d8][e] & 0xffffu) * bf2f(kv[e] & 0xffffu) + bf2f(qv[d8][e] >> 16) * bf2f(kv[e] >> 16); }
                sdot += __shfl_xor(sdot, 1); sdot += __shfl_xor(sdot, 2);
                if (mode) { sdot = sdot * att::SCALE + cumi - cumL[h * 16 + j]; if (j > i) sdot = -1e30f; mx = fmaxf(mx, sdot); } else { if (j > i) sdot = 0.f; }
                scL[tid * 17 + j] = sdot; }
            float o[32];
#pragma unroll
            for (int d = 0; d < 32; ++d) o[d] = 0.f;
            float l = 0.f;
#pragma unroll 1
            for (int j = 0; j < 16; ++j) { float p = scL[tid * 17 + j]; if (mode) { p = (j > i) ? 0.f : __expf(p - mx); l += p; }
#pragma unroll
                for (int d8 = 0; d8 < 4; ++d8) { const u32x4 vv = *(const LAS u32x4*)(Vp + j * 256 + d8 * 16);
#pragma unroll
                    for (int e = 0; e < 4; ++e) { o[d8 * 8 + 2 * e] += p * bf2f(vv[e] & 0xffffu); o[d8 * 8 + 2 * e + 1] += p * bf2f(vv[e] >> 16); } } }
            bf16_t* dst = MIX + (size_t)(MREAL + i) * DM + (mode ? 1024 : 0) + h * 128 + dq * 32;
            if (mode) { const float rl = 1.f / l;
#pragma unroll
                for (int d = 0; d < 32; d += 2) *(unsigned*)(dst + d) = cvt_pk_bf16(o[d] * rl, o[d + 1] * rl);
            } else { float sm = 0.f, qq = 0.f;
#pragma unroll
                for (int d = 0; d < 32; ++d) { sm += o[d]; qq += o[d] * o[d]; }
                sm += __shfl_xor(sm, 1); sm += __shfl_xor(sm, 2); qq += __shfl_xor(qq, 1); qq += __shfl_xor(qq, 2);
                const float mu = sm * (1.f / 128.f), var = fmaxf(qq * (1.f / 128.f) - mu * mu, 0.f), rs = rsqrtf(var + EPS);
                const bf16_t* gp = GT + (size_t)(MREAL + i) * 1024 + h * 128 + dq * 32; const float* gn = a.ret_gain + h * 128 + dq * 32;
#pragma unroll
                for (int d = 0; d < 32; d += 2) *(unsigned*)(dst + d) = cvt_pk_bf16((o[d] - mu) * rs * gn[d] * bf2f(gp[d]), (o[d + 1] - mu) * rs * gn[d + 1] * bf2f(gp[d + 1])); }
            __syncthreads();
        }
        __syncthreads();
    }
#endif
#ifndef NO_ATT
    {
#if defined(ONLY_FOX)
        const bool fox = true;
#elif defined(ONLY_RET)
        const bool fox = false;
#else
        const bool fox = bx < G / 2;
#endif
        struct MkF { __device__ __forceinline__ att::BlockRef operator()(int it, int ps) const { return mk_block_ref(it, ps, true); } };
        struct MkR { __device__ __forceinline__ att::BlockRef operator()(int it, int ps) const { return mk_block_ref(it, ps, false); } };
        if (fox) att::run<true>(bx, 128, G / 2, (char*)lds, (const char*)ws, a.ret_gain, MkF());
        else att::run<false>(bx - G / 2, 128, G / 2, (char*)lds, (const char*)ws, a.ret_gain, MkR());
    }
#endif
    }
#endif
    xcd_barrier(xbar);

#if PH(3)
    for (int rep_ = 0; rep_ < DUP(3); ++rep_) { PHASE_TID(); if (rep_) __syncthreads();
    if (bx < 128) {
        const int fr = lane & 15, fq = lane >> 4, col0 = bx * 16;
        const bf16_t* ap = MIX + (size_t)(MREAL + fr) * DM + wave * 256 + 8 * fq; const bf16_t* bp = WtOut + (size_t)(col0 + fr) * DM + wave * 256 + 8 * fq;
        bf16x8 av[8], bv[8];
#pragma unroll
        for (int i = 0; i < 8; ++i) { av[i] = *(const bf16x8*)(ap + 32 * i); bv[i] = *(const bf16x8*)(bp + 32 * i); }
        f32x4 acc = {0, 0, 0, 0};
#pragma unroll
        for (int i = 0; i < 8; ++i) acc = __builtin_amdgcn_mfma_f32_16x16x32_bf16(av[i], bv[i], acc, 0, 0, 0);
        LAS f32x4* red = (LAS f32x4*)L; red[wave * 64 + lane] = acc;
        __syncthreads();
        if (wave == 0) {
            f32x4 t = red[lane];
#pragma unroll
            for (int w = 1; w < 8; ++w) t += red[w * 64 + lane];
#pragma unroll
            for (int j = 0; j < 4; ++j) { const int row = fq * 4 + j, col = col0 + fr; const float hv = a.meta[(size_t)row * DM + col] + t[j];
                A2[(size_t)(MREAL + row) * DM + col] = (bf16_t)f2bf(hv);
                float q = hv * hv; q += __shfl_xor(q, 1); q += __shfl_xor(q, 2); q += __shfl_xor(q, 4); q += __shfl_xor(q, 8);
                if (fr == 0 && rep_ + 1 == DUP(3)) atomicAdd(ss2 + MREAL + row, q); }
        }
        __syncthreads();
    }
    {
        pg8::Gemm g{MIX, WtOut, MREAL, DM, DM}; pg8::StaticOrder S; S.init(MREAL, DM, G, bx);
        pg8::EpiOut E{A1, (const float*)(ws + OFF_IRS), A2, ss2, rep_ + 1 < DUP(3)};
        pg8::gemm_phase<pg8::EpiOut>(L, g, S, E);
    }
    }
#endif
    xcd_barrier(xbar);

#if PH(4)
    for (int rep_ = 0; rep_ < DUP(4); ++rep_) { PHASE_TID(); if (rep_) __syncthreads();
    {
        pg8::Gemm g{A2, WtUp, MPAD, NUP, DM}; pg8::StaticOrder S; S.init(MPAD, NUP, G, bx);
        pg8::EpiUp E{ACT, SIDE, ss2, a.conv_w, a.conv_b, L};
        pg8::gemm_phase<pg8::EpiUp>(L, g, S, E);
    }
    { constexpr int NU4 = (MPAD / 256) * (NUP / 256); const int first_idle = NU4 - 5 * G;
      if (first_idle > 0 && first_idle < G) { if (bx >= first_idle) tr_run(TR_N1 + (bx - first_idle) * 8 + wave, TR_NIT, (G - first_idle) * 8, (LAS float*)(L + wave * 16640), lane, a.w_in, a.w_out, a.w_up, a.w_down, a.g2, ws, a.g1); }
      else tr_run(TR_N1 + gw, TR_NIT, NGW, (LAS float*)(L + wave * 16640), lane, a.w_in, a.w_out, a.w_up, a.w_down, a.g2, ws, a.g1); }
    }
#endif
    xcd_barrier(xbar);

#if PH(6)
    for (int rep_ = 0; rep_ < DUP(6); ++rep_) { PHASE_TID(); if (rep_) __syncthreads();
    {
        pg8::Gemm g{ACT, WtDn, MREAL, DM, DFF}; pg8::StaticOrder S; S.init(MREAL, DM, G, bx);
        { pg8::Unit u0;
          if (S.next(0, u0)) {
            const int rg = u0.pn, gq = 4 * u0.pm + (rg >> 1), t = rg & 1;
            const bool bstart = (gq & 31) == 0;
            const int r0 = gq * 4 + t;
            const int r1 = t ? gq * 4 : (bstart ? 128 * 4 + 3 : (gq - 1) * 4 + 3);
            const int r2 = t ? (bstart ? 128 * 4 + 3 : (gq - 1) * 4 + 3) : (bstart ? 128 * 4 + 2 : (gq - 1) * 4 + 2);
            for (int c8 = tid; c8 < DFF / 8; c8 += 512) {
                const int ch = c8 * 8, col = 256 * (ch >> 7) + (ch & 127);
                const u32x4 g0r = *(const u32x4*)(SIDE + (size_t)r0 * NUP + col), v0r = *(const u32x4*)(SIDE + (size_t)r0 * NUP + col + 128);
                const u32x4 g1r = *(const u32x4*)(SIDE + (size_t)r1 * NUP + col), v1r = *(const u32x4*)(SIDE + (size_t)r1 * NUP + col + 128);
                const u32x4 g2r = *(const u32x4*)(SIDE + (size_t)r2 * NUP + col), v2r = *(const u32x4*)(SIDE + (size_t)r2 * NUP + col + 128);
                f32x4 wgv[3][2], wvv[3][2], bgv[2], bvv[2];
#pragma unroll
                for (int k = 0; k < 3; ++k)
#pragma unroll
                    for (int q = 0; q < 2; ++q) { wgv[k][q] = *(const f32x4*)(a.conv_w + k * NUP + ch + 4 * q); wvv[k][q] = *(const f32x4*)(a.conv_w + k * NUP + DFF + ch + 4 * q); }
#pragma unroll
                for (int q = 0; q < 2; ++q) { bgv[q] = *(const f32x4*)(a.conv_b + ch + 4 * q); bvv[q] = *(const f32x4*)(a.conv_b + DFF + ch + 4 * q); }
                float res[8];
#pragma unroll
                for (int j = 0; j < 8; ++j) { const int w = j >> 1, sh = (j & 1) * 16, q = j >> 2, e = j & 3;
                    const float ga = bf2f((g2r[w] >> sh) & 0xffffu), gb = bf2f((g1r[w] >> sh) & 0xffffu), gc = bf2f((g0r[w] >> sh) & 0xffffu);
                    const float va = bf2f((v2r[w] >> sh) & 0xffffu), vb = bf2f((v1r[w] >> sh) & 0xffffu), vc = bf2f((v0r[w] >> sh) & 0xffffu);
                    const float yg = bgv[q][e] + wgv[0][q][e] * ga + wgv[1][q][e] * gb + wgv[2][q][e] * gc;
                    const float yv = bvv[q][e] + wvv[0][q][e] * va + wvv[1][q][e] * vb + wvv[2][q][e] * vc;
                    res[j] = silu_f(yg) * yv; }
                u32x4 w; w.x = cvt_pk_bf16(res[0], res[1]); w.y = cvt_pk_bf16(res[2], res[3]); w.z = cvt_pk_bf16(res[4], res[5]); w.w = cvt_pk_bf16(res[6], res[7]);
                st_wt16(ACT + (size_t)(gq * 64 + t) * DFF + ch, w);
            }
            asm volatile("s_waitcnt vmcnt(0)" ::: "memory");
            __syncthreads();
            if (tid == 0) { unsigned* c = (unsigned*)(ws + OFF_H1M + 24576) + 64 * u0.pm;
                __hip_atomic_fetch_add(c, 1u, __ATOMIC_RELAXED, __HIP_MEMORY_SCOPE_AGENT);
                unsigned sp = 0; while (__hip_atomic_load(c, __ATOMIC_RELAXED, __HIP_MEMORY_SCOPE_AGENT) < 8u) { __builtin_amdgcn_s_sleep(4); if (++sp > (1u << 20)) break; } }
            __syncthreads();
          } }
        pg8::EpiDown E{a.out, A2, ss3, (unsigned*)(ws + OFF_H1M + 16384), a.gf};
        pg8::gemm_phase<pg8::EpiDown>(L, g, S, E);
    }
    }
#endif
}

extern "C" void kernel_launch(void* const* d_in, const int* in_sizes, int n_in, void* d_out, int out_size, void* d_ws, size_t ws_size, hipStream_t stream) {
    static int grid = 0;
    if (grid == 0) {
        if (n_in != 13 || out_size != MREAL * DM || ws_size < WS_END) { fprintf(stderr, "kernel_launch: unexpected shapes (n_in %d out %d ws %zu, need %zu)\n", n_in, out_size, ws_size, (size_t)WS_END); grid = -1; return; }
        int dev = 0, cus = 0, per_cu = 0;
        (void)hipGetDevice(&dev);
        (void)hipDeviceGetAttribute(&cus, hipDeviceAttributeMultiprocessorCount, dev);
        (void)hipFuncSetAttribute((const void*)mk_fwd, hipFuncAttributeMaxDynamicSharedMemorySize, LDS_BYTES);
        (void)hipOccupancyMaxActiveBlocksPerMultiprocessor(&per_cu, (const void*)mk_fwd, 512, LDS_BYTES);
        (void)hipGetLastError();
        if (cus != 256 || per_cu < 1) fprintf(stderr, "kernel_launch: cus %d per_cu %d\n", cus, per_cu);
        grid = 256;
    }
    if (grid < 0) return;
    Args a{};
    a.x = (const float*)d_in[0]; a.meta = (const float*)d_in[1]; a.g1 = (const float*)d_in[2]; a.w_in = (const float*)d_in[3]; a.b_forget = (const float*)d_in[4];
    a.ret_gain = (const float*)d_in[5]; a.w_out = (const float*)d_in[6]; a.g2 = (const float*)d_in[7]; a.w_up = (const float*)d_in[8]; a.conv_w = (const float*)d_in[9];
    a.conv_b = (const float*)d_in[10]; a.w_down = (const float*)d_in[11]; a.gf = (const float*)d_in[12];
    a.out = (float*)d_out; a.ws = (unsigned char*)d_ws;
    if (hipMemsetAsync((char*)d_ws + OFF_H1M, 0, 16384 + 2 * 32 * 256, stream) != hipSuccess) { fprintf(stderr, "kernel_launch: memset failed\n"); return; }
    void* args[] = {&a};
    hipError_t e = hipLaunchCooperativeKernel((const void*)mk_fwd, dim3(grid), dim3(512), args, LDS_BYTES, stream);
    if (e != hipSuccess) fprintf(stderr, "kernel_launch: cooperative launch failed: %s\n", hipGetErrorString(e));
}
```

```cpp
#include <hip/hip_runtime.h>
#include <hip/hip_cooperative_groups.h>
#include <cstdio>
#include <cstdint>
namespace cg = cooperative_groups;

#define LAS __attribute__((address_space(3)))
typedef unsigned short bf16_t;
typedef short bf16x8 __attribute__((ext_vector_type(8)));
typedef short s16x4 __attribute__((ext_vector_type(4)));
typedef float f32x2 __attribute__((ext_vector_type(2)));
typedef float f32x4 __attribute__((ext_vector_type(4)));
typedef float f32x16 __attribute__((ext_vector_type(16)));
typedef unsigned u32x2 __attribute__((ext_vector_type(2)));
typedef unsigned u32x4 __attribute__((ext_vector_type(4)));

constexpr int DM = 2048, NB = 4, SEQ = 2048, NMETA = 16, LTOT = SEQ + NMETA;
constexpr int MREAL = NB * SEQ;
constexpr int MPAD = MREAL + 256;
constexpr int NH = 8, HD = 128;
constexpr int NPROJ = 7168;
constexpr int INDIM = 7176;
constexpr int DFF = 5632, NUP = 2 * DFF;
constexpr int KVP = 2112;
constexpr float EPS = 1e-6f;
constexpr int LDS_BYTES = 147456;

constexpr size_t OFF_SS2 = 0;
constexpr size_t OFF_SS3 = 65536;
constexpr size_t OFF_LOGF = 131072;
constexpr size_t OFF_IRS = 425984;
constexpr size_t OFF_COS = 524288;
constexpr size_t OFF_SIN = 1310720;
constexpr size_t OFF_DEC = 2097152;
constexpr size_t OFF_DECI = 2228224;
constexpr size_t OFF_QX = 2621440;
constexpr size_t OFF_KX = 4194304;
constexpr size_t OFF_QM = 5767168;
constexpr size_t OFF_H1M = 6029312;
constexpr size_t OFF_A = 6291456;
constexpr size_t OFF_WTIN = OFF_A;
constexpr size_t OFF_WTOUT = OFF_WTIN + (size_t)NPROJ * DM * 2;
constexpr size_t OFF_WTUP = OFF_WTOUT + (size_t)DM * DM * 2;
constexpr size_t OFF_A2 = OFF_WTUP + (size_t)NUP * DM * 2;
constexpr size_t SZ_SIDE = (size_t)132 * 4 * NUP * 2;
constexpr size_t OFF_WTDN = OFF_A2 + (size_t)MPAD * DM * 2;
constexpr size_t OFF_B = OFF_WTDN + (size_t)DM * DFF * 2;
constexpr size_t OFF_SIDE = OFF_B;
constexpr size_t OFF_ACT = OFF_B + 16777216;
constexpr size_t OFF_A1 = OFF_B;
constexpr size_t SZ_Q = (size_t)NB * NH * SEQ * HD * 2, SZ_K = (size_t)NB * NH * KVP * HD * 2;
constexpr size_t OFF_RQ = OFF_A1 + (size_t)MPAD * DM * 2;
constexpr size_t OFF_RK = OFF_RQ + SZ_Q;
constexpr size_t OFF_RV = OFF_RK + SZ_K;
constexpr size_t OFF_FQ = OFF_RV + SZ_K;
constexpr size_t OFF_FK = OFF_FQ + SZ_Q;
constexpr size_t OFF_FV = OFF_FK + SZ_K;
constexpr size_t OFF_G = OFF_FV + SZ_K;
constexpr size_t OFF_MIX = OFF_G + (size_t)MPAD * 1024 * 2;
constexpr size_t WS_END = OFF_MIX + (size_t)MPAD * DM * 2;
static_assert(OFF_MIX + (size_t)MPAD * DM * 2 <= WS_END, "region B overlay");
static_assert(OFF_ACT + (size_t)MREAL * DFF * 2 <= WS_END && SZ_SIDE <= 16777216, "act overlay");
static_assert(WS_END <= 369000000ull, "workspace");

__device__ __forceinline__ unsigned cvt_pk_bf16(float lo, float hi) { unsigned r; asm volatile("v_cvt_pk_bf16_f32 %0, %1, %2" : "=v"(r) : "v"(lo), "v"(hi)); return r; }
__device__ __forceinline__ unsigned f2bf(float f) { unsigned u = __builtin_bit_cast(unsigned, f); return (u + 0x7fffu + ((u >> 16) & 1u)) >> 16; }
__device__ __forceinline__ float bf2f(unsigned b) { return __builtin_bit_cast(float, b << 16); }
__device__ __forceinline__ unsigned pk2(float lo, float hi) { return f2bf(lo) | (f2bf(hi) << 16); }
__device__ __forceinline__ void st_wt16(void* p, u32x4 v) { asm volatile("global_store_dwordx4 %0, %1, off sc1\n\ts_nop 1" :: "v"(p), "v"(v) : "memory"); }
__device__ __forceinline__ float silu_f(float v) { return v * __builtin_amdgcn_rcpf(1.f + __builtin_amdgcn_exp2f(v * -1.4426950408889634f)); }

namespace pg8 {
constexpr int BM = 256, BK = 64, HALF = 128, HTB = HALF * BK * 2, STAGE_BYTES = 8 * HTB, NXCD = 8, WGM = 4;
__host__ __device__ __forceinline__ int lds_byte(int r, int c) { const int st = (r >> 4) * 2 + (c >> 5), rr = r & 15, cc = c & 31, ob = rr * 64 + cc * 2; return st * 1024 + (ob ^ (((ob >> 9) & 1) << 5)); }
__host__ __device__ __forceinline__ void stage_rc(int b, int& R, int& C) { const int st = b / 1024, sb = b % 1024, swz = sb ^ (((sb >> 9) & 1) << 5); R = (st >> 1) * 16 + swz / 64; C = (st & 1) * 32 + (swz % 64) / 2; }
__host__ __device__ __forceinline__ int perm32(int rho) { const int n = rho >> 4, i = rho & 15; return 8 * (i >> 2) + 4 * n + (i & 3); }
struct Unit { int pm, pn; };
struct Gemm { const bf16_t* A; const bf16_t* Bt; int M, N, K; };
struct StaticOrder {
    int nM, nN, nwg, G, c, wgm;
    __host__ __device__ void init(int M, int N, int G_, int c_, int wgm_ = WGM) { nM = M / BM; nN = N / BM; nwg = nM * nN; G = G_; c = c_; wgm = wgm_; }
    __host__ __device__ __forceinline__ bool next(int i, Unit& u) const {
        const long L = (long)i * G + c; if (L >= nwg) return false;
        int wgid = (int)L; { const int q = nwg / NXCD, r = nwg % NXCD, xcd = wgid % NXCD, off = wgid / NXCD; wgid = (xcd < r ? xcd * (q + 1) : r * (q + 1) + (xcd - r) * q) + off; }
        const int nig = wgm * nN, gid = wgid / nig, fm = gid * wgm, gsz = (nM - fm) < wgm ? (nM - fm) : wgm;
        u.pm = fm + ((wgid % nig) % gsz); u.pn = (wgid % nig) / gsz; return true;
    }
};
template <class Epi>
__device__ __forceinline__ void gemm_phase(LAS unsigned char* lds, const Gemm g, const StaticOrder& S, const Epi& E) {
    int tid = threadIdx.x; asm volatile("" : "+v"(tid));
    const int wid = __builtin_amdgcn_readfirstlane(tid >> 6), lane = tid & 63, wr = wid >> 2, wc = wid & 3, fr = lane & 15, fq = lane >> 4;
    const int K = g.K, nt = K / BK;
    unsigned voffA[2], voffB[2];
#pragma unroll
    for (int i = 0; i < 2; ++i) { int R, C; stage_rc(tid * 16 + i * 8192, R, C); const int Rb = Epi::PERM ? ((R & ~31) + perm32(R & 31)) : R;
        voffA[i] = (unsigned)(R * K + C) * 2u; voffB[i] = (unsigned)(Rb * K + C) * 2u; }
    const size_t kstep = (size_t)(BK * 2);
    const size_t hstep = (size_t)HALF * K * 2;
    const size_t tstep = 2 * hstep;
    const unsigned ldsw = (unsigned)wid * 1024u;
    const int aoff = lds_byte(wr * 64 + fr, fq * 8), boff = lds_byte(wc * 32 + fr, fq * 8);
#define PG8_SA(b, h) (((b) * 2 + (h)) * HTB)
#define PG8_SB(b, h) ((4 + (b) * 2 + (h)) * HTB)
#define PG8_STAGE(bufoff, gbase, voff) do { _Pragma("unroll") for (int _i = 0; _i < 2; ++_i) \
        __builtin_amdgcn_global_load_lds((const unsigned*)((const char*)(gbase) + (voff)[_i]), (LAS unsigned*)(lds + (bufoff) + ldsw + _i * 8192), 16, 0, 0); } while (0)
#define PG8_LDA(dst, b, h) do { _Pragma("unroll") for (int m = 0; m < 4; ++m) _Pragma("unroll") for (int k = 0; k < 2; ++k) dst[m][k] = *(const LAS bf16x8*)(lds + PG8_SA(b, h) + aoff + m * 2048 + k * 1024); } while (0)
#define PG8_LDB(dst, b, h) do { _Pragma("unroll") for (int n = 0; n < 2; ++n) _Pragma("unroll") for (int k = 0; k < 2; ++k) dst[n][k] = *(const LAS bf16x8*)(lds + PG8_SB(b, h) + boff + n * 2048 + k * 1024); } while (0)
#define PG8_MMA(ai, bj, At, Bt) do { __builtin_amdgcn_s_setprio(1); _Pragma("unroll") for (int m = 0; m < 4; ++m) _Pragma("unroll") for (int n = 0; n < 2; ++n) _Pragma("unroll") for (int k = 0; k < 2; ++k) \
        acc[ai][bj][m][n] = __builtin_amdgcn_mfma_f32_16x16x32_bf16(Bt[n][k], At[m][k], acc[ai][bj][m][n], 0, 0, 0); __builtin_amdgcn_s_setprio(0); } while (0)
#define PG8_WAIT_V(n) asm volatile("s_waitcnt vmcnt(" #n ")" ::: "memory")
#define PG8_WAIT_L(n) asm volatile("s_waitcnt lgkmcnt(" #n ")" ::: "memory")
#define PG8_BAR __builtin_amdgcn_s_barrier()
#define PG8_SCHED __builtin_amdgcn_sched_barrier(0)
    Unit cur, nxt; int ui = 0;
    if (!S.next(0, cur)) return;
    f32x4 acc[2][2][4][2];
#pragma unroll
    for (int a = 0; a < 2; ++a)
#pragma unroll
        for (int b = 0; b < 2; ++b)
#pragma unroll
            for (int m = 0; m < 4; ++m)
#pragma unroll
                for (int n = 0; n < 2; ++n) acc[a][b][m][n] = (f32x4){0.f, 0.f, 0.f, 0.f};
    bf16x8 At[4][2], B0[2][2], B1[2][2];
    const char* cA = (const char*)g.A + (size_t)cur.pm * tstep; const char* cB = (const char*)g.Bt + (size_t)cur.pn * tstep;
    PG8_STAGE(PG8_SB(0, 0), cB, voffB); PG8_STAGE(PG8_SB(0, 1), cB + hstep, voffB); PG8_STAGE(PG8_SA(0, 0), cA, voffA); PG8_STAGE(PG8_SA(0, 1), cA + hstep, voffA);
    if (wr == 1) PG8_BAR;
    PG8_WAIT_V(2); PG8_BAR;
    PG8_STAGE(PG8_SB(1, 0), cB + kstep, voffB); PG8_STAGE(PG8_SA(1, 0), cA + kstep, voffA); PG8_STAGE(PG8_SB(1, 1), cB + hstep + kstep, voffB);
    PG8_WAIT_V(6); PG8_BAR;
    for (;;) {
        const bool has_next = S.next(ui + 1, nxt);
        const char* nA = has_next ? (const char*)g.A + (size_t)nxt.pm * tstep : cA; const char* nB = has_next ? (const char*)g.Bt + (size_t)nxt.pn * tstep : cB;
        for (int t = 0; t < nt; t += 2) {
            const bool last = (t == nt - 2);
            const char* a1 = cA + (size_t)(t + 1) * kstep;
            const char* a2 = last ? nA : cA + (size_t)(t + 2) * kstep; const char* b2 = last ? nB : cB + (size_t)(t + 2) * kstep;
            const char* a3 = a2 + kstep; const char* b3 = b2 + kstep;
            PG8_LDB(B0, 0, 0); PG8_LDB(B1, 0, 1); PG8_SCHED; PG8_LDA(At, 0, 0); PG8_STAGE(PG8_SA(1, 1), a1 + hstep, voffA);
            PG8_WAIT_V(8); PG8_WAIT_L(0); PG8_BAR; PG8_MMA(0, 0, At, B0); PG8_MMA(0, 1, At, B1); PG8_BAR; PG8_SCHED;
            PG8_LDA(At, 0, 1); PG8_STAGE(PG8_SB(0, 0), b2, voffB); PG8_STAGE(PG8_SB(0, 1), b2 + hstep, voffB); PG8_STAGE(PG8_SA(0, 0), a2, voffA);
            PG8_WAIT_V(8); PG8_WAIT_L(0); PG8_BAR; PG8_MMA(1, 0, At, B0); PG8_MMA(1, 1, At, B1); PG8_BAR; PG8_SCHED;
            PG8_LDB(B0, 1, 0); PG8_LDB(B1, 1, 1); PG8_SCHED; PG8_LDA(At, 1, 0); PG8_STAGE(PG8_SA(0, 1), a2 + hstep, voffA);
            PG8_WAIT_V(8); PG8_WAIT_L(0); PG8_BAR; PG8_MMA(0, 0, At, B0); PG8_MMA(0, 1, At, B1); PG8_BAR; PG8_SCHED;
            PG8_LDA(At, 1, 1); PG8_STAGE(PG8_SB(1, 0), b3, voffB); PG8_STAGE(PG8_SB(1, 1), b3 + hstep, voffB); PG8_STAGE(PG8_SA(1, 0), a3, voffA);
            PG8_WAIT_V(8); PG8_WAIT_L(0); PG8_BAR; PG8_MMA(1, 0, At, B0); PG8_MMA(1, 1, At, B1); PG8_BAR; PG8_SCHED;
        }
        if (wr == 0) PG8_BAR;
        E(acc, cur, wr, wc, fr, fq);
        if (!has_next) break;
#pragma unroll
        for (int a = 0; a < 2; ++a)
#pragma unroll
            for (int b = 0; b < 2; ++b)
#pragma unroll
                for (int m = 0; m < 4; ++m)
#pragma unroll
                    for (int n = 0; n < 2; ++n) acc[a][b][m][n] = (f32x4){0.f, 0.f, 0.f, 0.f};
        cur = nxt; cA = nA; cB = nB; ++ui;
        if (wr == 1) PG8_BAR;
    }
    PG8_WAIT_V(0);
    PG8_BAR;
#undef PG8_SA
#undef PG8_SB
#undef PG8_STAGE
#undef PG8_LDA
#undef PG8_LDB
#undef PG8_MMA
#undef PG8_WAIT_V
#undef PG8_WAIT_L
#undef PG8_BAR
#undef PG8_SCHED
}

struct EpiProj {
    static constexpr bool PERM = true;
    unsigned char* ws;
    __device__ __forceinline__ void operator()(const f32x4 (&acc)[2][2][4][2], const Unit& u, int wr, int wc, int fr, int fq) const {
        const int region = u.pn >> 2, hp = (u.pn & 3) * 2;
        bf16_t* const RQ = (bf16_t*)(ws + OFF_RQ); bf16_t* const RK = (bf16_t*)(ws + OFF_RK); bf16_t* const RV = (bf16_t*)(ws + OFF_RV);
        bf16_t* const FQ = (bf16_t*)(ws + OFF_FQ); bf16_t* const FK = (bf16_t*)(ws + OFF_FK); bf16_t* const FV = (bf16_t*)(ws + OFF_FV);
        bf16_t* const G = (bf16_t*)(ws + OFF_G); bf16_t* const QM = (bf16_t*)(ws + OFF_QM);
        const float* const cosT = (const float*)(ws + OFF_COS); const float* const sinT = (const float*)(ws + OFF_SIN);
        const float* const dec = (const float*)(ws + OFF_DEC); const float* const deci = (const float*)(ws + OFF_DECI);
        const bool meta = (u.pm == 32);
        const int cih = 32 * wc + 8 * fq;
        const int d0 = 16 * wc + 4 * fq;
#pragma unroll
        for (int ai = 0; ai < 2; ++ai) {
          f32x4 c4v[4], s4v[4]; float fv[4][2];
          if (region <= 1) {
#pragma unroll
            for (int m = 0; m < 4; ++m) { const int rt = ai * 128 + wr * 64 + m * 16 + fr; const int row = u.pm * 256 + rt; const int pos = meta ? (rt & 15) : NMETA + (row & 2047);
                c4v[m] = *(const f32x4*)(cosT + pos * 64 + d0); s4v[m] = *(const f32x4*)(sinT + pos * 64 + d0);
                fv[m][0] = (region == 0 ? dec : deci)[hp * LTOT + pos]; fv[m][1] = (region == 0 ? dec : deci)[(hp + 1) * LTOT + pos]; }
          }
#pragma unroll
            for (int m = 0; m < 4; ++m) {
                const int rt = ai * 128 + wr * 64 + m * 16 + fr;
                if (meta && (ai | m | wr) != 0) continue;
                const int row = u.pm * 256 + rt;
                const int b = (row >> 11) & 3, s = row & 2047, pos = meta ? rt : NMETA + s;
                const f32x4 c4 = c4v[m], s4 = s4v[m];
#pragma unroll
                for (int bj = 0; bj < 2; ++bj) {
                    const int hh = hp + bj;
                    f32x4 v0 = acc[ai][bj][m][0], v1 = acc[ai][bj][m][1];
                    if (region <= 1) {
                        const float f = fv[m][bj];
                        const f32x4 o0 = (v0 * c4 - v1 * s4) * f, o1 = (v0 * s4 + v1 * c4) * f; v0 = o0; v1 = o1;
                    } else if (region == 3) {
#pragma unroll
                        for (int j = 0; j < 4; ++j) { v0[j] = silu_f(v0[j]); v1[j] = silu_f(v1[j]); }
                    }
                    u32x4 w; w.x = cvt_pk_bf16(v0[0], v0[1]); w.y = cvt_pk_bf16(v0[2], v0[3]); w.z = cvt_pk_bf16(v1[0], v1[1]); w.w = cvt_pk_bf16(v1[2], v1[3]);
                    if (region == 3) { *(u32x4*)(G + (size_t)row * 1024 + hh * 128 + cih) = w; }
                    else if (region == 0 || region == 4) {
                        if (meta) *(u32x4*)(QM + (size_t)(((region == 4 ? 8 : 0) + hh) * 16 + rt) * 128 + cih) = w;
                        else *(u32x4*)((region == 0 ? RQ : FQ) + ((size_t)(b * 8 + hh) * SEQ + s) * 128 + cih) = w;
                    } else {
                        bf16_t* base = region == 1 ? RK : region == 2 ? RV : region == 5 ? FK : FV;
                        if (meta) {
#pragma unroll
                            for (int bb = 0; bb < 4; ++bb) *(u32x4*)(base + ((size_t)(bb * 8 + hh) * KVP + pos) * 128 + cih) = w;
                        } else *(u32x4*)(base + ((size_t)(b * 8 + hh) * KVP + pos) * 128 + cih) = w;
                    }
                }
            }
        }
    }
};
struct EpiOut {
    static constexpr bool PERM = true;
    const bf16_t* A1; const float* irs; bf16_t* A2; float* ss; int dry;
    __device__ __forceinline__ void operator()(const f32x4 (&acc)[2][2][4][2], const Unit& u, int wr, int wc, int fr, int fq) const {
        const int col0 = u.pn * 256 + wc * 32 + 8 * fq;
#pragma unroll
        for (int ai = 0; ai < 2; ++ai) {
            u32x4 xv[4][2]; float ir[4];
#pragma unroll
            for (int m = 0; m < 4; ++m) { const int row = u.pm * 256 + ai * 128 + wr * 64 + m * 16 + fr; ir[m] = irs[row];
#pragma unroll
                for (int bj = 0; bj < 2; ++bj) xv[m][bj] = *(const u32x4*)(A1 + (size_t)row * DM + col0 + bj * 128); }
#pragma unroll
            for (int m = 0; m < 4; ++m) {
                const int row = u.pm * 256 + ai * 128 + wr * 64 + m * 16 + fr; const size_t off = (size_t)row * DM + col0; float q = 0.f;
#pragma unroll
                for (int bj = 0; bj < 2; ++bj) { const u32x4 xb = xv[m][bj];
                    const f32x4 x0 = (f32x4){bf2f(xb.x & 0xffffu), bf2f(xb.x >> 16), bf2f(xb.y & 0xffffu), bf2f(xb.y >> 16)} * ir[m];
                    const f32x4 x1 = (f32x4){bf2f(xb.z & 0xffffu), bf2f(xb.z >> 16), bf2f(xb.w & 0xffffu), bf2f(xb.w >> 16)} * ir[m];
                    const f32x4 h0 = x0 + acc[ai][bj][m][0], h1 = x1 + acc[ai][bj][m][1];
                    u32x4 w; w.x = cvt_pk_bf16(h0[0], h0[1]); w.y = cvt_pk_bf16(h0[2], h0[3]); w.z = cvt_pk_bf16(h1[0], h1[1]); w.w = cvt_pk_bf16(h1[2], h1[3]);
                    *(u32x4*)(A2 + off + bj * 128) = w;
                    q += ((h0[0] * h0[0] + h0[1] * h0[1]) + (h0[2] * h0[2] + h0[3] * h0[3])) + ((h1[0] * h1[0] + h1[1] * h1[1]) + (h1[2] * h1[2] + h1[3] * h1[3])); }
                q += __shfl_xor(q, 16); q += __shfl_xor(q, 32);
                if (fq == 0 && !dry) atomicAdd(ss + row, q);
            }
        }
    }
};
template <int CTRL> __device__ __forceinline__ float dpp_ror(float src) { return __builtin_bit_cast(float, __builtin_amdgcn_update_dpp(0, __builtin_bit_cast(int, src), CTRL, 0xf, 0xf, true)); }
struct EpiUp {
    static constexpr bool PERM = true;
    bf16_t* ACTp; bf16_t* SIDEp; const float* ss; const float* cw; const float* cb; LAS unsigned char* ldsx;
    __device__ __forceinline__ void side_store(int grp, int slot, int pn, int c8h, const f32x4& cG, const f32x4& cV) const {
        bf16_t* sp = SIDEp + (size_t)(grp * 4 + slot) * NUP + pn * 256 + c8h;
        u32x2 a_; a_.x = cvt_pk_bf16(cG[0], cG[1]); a_.y = cvt_pk_bf16(cG[2], cG[3]); *(u32x2*)sp = a_;
        u32x2 b_; b_.x = cvt_pk_bf16(cV[0], cV[1]); b_.y = cvt_pk_bf16(cV[2], cV[3]); *(u32x2*)(sp + 128) = b_;
    }
    __device__ __forceinline__ void operator()(const f32x4 (&acc)[2][2][4][2], const Unit& u, int wr, int wc, int fr, int fq) const {
        const int c8 = wc * 32 + 8 * fq, ch0 = u.pn * 128 + c8;
        const bool l1 = fr < 1, l2 = fr < 2, meta = u.pm == 32;
        u32x2 stash[2][4];
        LAS float* wl = (LAS float*)(ldsx + 131072 + (wr * 4 + wc) * 1024);
        { const int lane_ = fq * 16 + fr, p = lane_ >> 3, chl = 4 * (lane_ & 7), chb = u.pn * 128 + wc * 32 + chl;
          const float* src = (p & 3) == 3 ? cb + (p >> 2) * DFF + chb : cw + (p & 3) * NUP + (p >> 2) * DFF + chb;
          *(LAS f32x4*)(wl + p * 32 + chl) = *(const f32x4*)src; }
        float rsv[2][4];
#pragma unroll
        for (int ai = 0; ai < 2; ++ai)
#pragma unroll
            for (int m = 0; m < 4; ++m) rsv[ai][m] = ss[u.pm * 256 + ai * 128 + wr * 64 + m * 16 + fr];
#pragma unroll
        for (int ai = 0; ai < 2; ++ai)
#pragma unroll
            for (int m = 0; m < 4; ++m) rsv[ai][m] = __builtin_amdgcn_rsqf(rsv[ai][m] * (1.f / DM) + EPS);
#pragma unroll
        for (int half = 0; half < 2; ++half) {
            const LAS float* wq = wl + 8 * fq + 4 * half;
            const f32x4 wg0 = *(const LAS f32x4*)(wq), wg1 = *(const LAS f32x4*)(wq + 32), wg2 = *(const LAS f32x4*)(wq + 64), bg = *(const LAS f32x4*)(wq + 96);
            const f32x4 wv0 = *(const LAS f32x4*)(wq + 128), wv1 = *(const LAS f32x4*)(wq + 160), wv2 = *(const LAS f32x4*)(wq + 192), bv = *(const LAS f32x4*)(wq + 224);
#pragma unroll
            for (int ai = 0; ai < 2; ++ai) {
                f32x4 r1G = {0, 0, 0, 0}, r2G = {0, 0, 0, 0}, r1V = {0, 0, 0, 0}, r2V = {0, 0, 0, 0};
                const int grp = u.pm * 4 + ai * 2 + wr;
#pragma unroll
                for (int m = 0; m < 4; ++m) {
                    const int row = u.pm * 256 + ai * 128 + wr * 64 + m * 16 + fr; const float rs = rsv[ai][m];
                    const f32x4 cG = acc[ai][0][m][half] * rs, cV = acc[ai][1][m][half] * rs;
                    f32x4 c1G, c2G, c1V, c2V, G1, G2, V1, V2;
#pragma unroll
                    for (int j = 0; j < 4; ++j) { c1G[j] = dpp_ror<0x121>(cG[j]); c2G[j] = dpp_ror<0x122>(cG[j]); c1V[j] = dpp_ror<0x121>(cV[j]); c2V[j] = dpp_ror<0x122>(cV[j]);
                        G1[j] = l1 ? r1G[j] : c1G[j]; G2[j] = l2 ? r2G[j] : c2G[j]; V1[j] = l1 ? r1V[j] : c1V[j]; V2[j] = l2 ? r2V[j] : c2V[j]; }
                    const f32x4 yg = bg + wg0 * G2 + wg1 * G1 + wg2 * cG, yv = bv + wv0 * V2 + wv1 * V1 + wv2 * cV;
                    f32x4 res;
#pragma unroll
                    for (int j = 0; j < 4; ++j) res[j] = silu_f(yg[j]) * yv[j];
                    u32x2 pk; pk.x = cvt_pk_bf16(res[0], res[1]); pk.y = cvt_pk_bf16(res[2], res[3]);
                    if (half == 0) stash[ai][m] = pk;
                    else if (!meta && !(m == 0 && l2)) { u32x4 w; w.x = stash[ai][m].x; w.y = stash[ai][m].y; w.z = pk.x; w.w = pk.y; *(u32x4*)(ACTp + (size_t)row * DFF + ch0) = w; }
                    if (!meta) { if (m == 0) { if (l2) side_store(grp, fr, u.pn, c8 + 4 * half, cG, cV); }
                                 if (m == 3) { if (fr >= 14) side_store(grp, fr - 12, u.pn, c8 + 4 * half, cG, cV); } }
                    else if (ai == 0 && m == 0) { if (wr == 0 && fr >= 14) side_store(128, fr - 12, u.pn, c8 + 4 * half, cG, cV); }
                    r1G = c1G; r2G = c2G; r1V = c1V; r2V = c2V;
                }
            }
        }
    }
};
struct EpiDown {
    static constexpr bool PERM = true;
    float* out; const bf16_t* A2; float* ss; unsigned* cnt; const float* gf;
    __device__ __forceinline__ void operator()(f32x4 (&acc)[2][2][4][2], const Unit& u, int wr, int wc, int fr, int fq) const {
        const int col0 = u.pn * 256 + wc * 32 + 8 * fq;
#pragma unroll
        for (int ai = 0; ai < 2; ++ai) {
            f32x4 hv[4][2][2];
#pragma unroll
            for (int m = 0; m < 4; ++m)
#pragma unroll
                for (int bj = 0; bj < 2; ++bj)
#pragma unroll
                    for (int n = 0; n < 2; ++n) { const u32x2 hb = *(const u32x2*)(A2 + (size_t)(u.pm * 256 + ai * 128 + wr * 64 + m * 16 + fr) * DM + col0 + bj * 128 + n * 4);
                        hv[m][bj][n] = (f32x4){bf2f(hb.x & 0xffffu), bf2f(hb.x >> 16), bf2f(hb.y & 0xffffu), bf2f(hb.y >> 16)}; }
#pragma unroll
            for (int m = 0; m < 4; ++m) {
                const int row = u.pm * 256 + ai * 128 + wr * 64 + m * 16 + fr; float q = 0.f;
#pragma unroll
                for (int bj = 0; bj < 2; ++bj)
#pragma unroll
                    for (int n = 0; n < 2; ++n) { const f32x4 h = hv[m][bj][n] + acc[ai][bj][m][n];
                        acc[ai][bj][m][n] = h; q += (h[0] * h[0] + h[1] * h[1]) + (h[2] * h[2] + h[3] * h[3]); }
                q += __shfl_xor(q, 16); q += __shfl_xor(q, 32);
                if (fq == 0) { const float old_ = atomicAdd(ss + row, q); asm volatile("" :: "v"(old_)); }
            }
        }
        asm volatile("s_waitcnt vmcnt(0)" ::: "memory");
        __builtin_amdgcn_s_barrier();
        unsigned* c = cnt + 64 * u.pm;
        if (wr == 0 && wc == 0) {
            if ((fr | fq) == 0) __hip_atomic_fetch_add(c, 1u, __ATOMIC_RELAXED, __HIP_MEMORY_SCOPE_AGENT);
            unsigned sp = 0; while ((unsigned)__builtin_amdgcn_readfirstlane(__hip_atomic_load(c, __ATOMIC_RELAXED, __HIP_MEMORY_SCOPE_AGENT)) < 8u) { __builtin_amdgcn_s_sleep(8); if (++sp > (1u << 20)) break; }
        }
        __builtin_amdgcn_s_barrier();
        f32x4 gv[2][2];
#pragma unroll
        for (int bj = 0; bj < 2; ++bj)
#pragma unroll
            for (int n = 0; n < 2; ++n) gv[bj][n] = *(const f32x4*)(gf + col0 + bj * 128 + n * 4);
        float sv[2][4];
#pragma unroll
        for (int ai = 0; ai < 2; ++ai)
#pragma unroll
            for (int m = 0; m < 4; ++m) sv[ai][m] = __hip_atomic_load(ss + u.pm * 256 + ai * 128 + wr * 64 + m * 16 + fr, __ATOMIC_RELAXED, __HIP_MEMORY_SCOPE_AGENT);
#pragma unroll
        for (int ai = 0; ai < 2; ++ai)
#pragma unroll
            for (int m = 0; m < 4; ++m) {
                const int row = u.pm * 256 + ai * 128 + wr * 64 + m * 16 + fr; const size_t off = (size_t)row * DM + col0;
                const float rs = rsqrtf(sv[ai][m] * (1.f / DM) + EPS);
#pragma unroll
                for (int bj = 0; bj < 2; ++bj)
#pragma unroll
                    for (int n = 0; n < 2; ++n) *(f32x4*)(out + off + bj * 128 + n * 4) = acc[ai][bj][m][n] * rs * gv[bj][n];
            }
    }
};
}

namespace att {
constexpr int NW = 8, QBLK = 32, KVBLK = 64, QB = NW * QBLK, D = 128;
constexpr int SHM_V = KVBLK * D * 2, SHM_K = KVBLK * D * 2;
constexpr int OFF_WSF = 2 * SHM_V + 2 * SHM_K, OFF_X = OFF_WSF + NW * 64 * 4, OFF_QXL = OFF_X + 2048, OFF_QL = OFF_QXL + 8192;
constexpr float SCALE = 0.08838834764831845f;
constexpr float THR = 8.f;
#define KSWZ(row, colB) ((row) * 256 + ((colB) ^ (((row) & 15) << 4)))
#define SBAR() __builtin_amdgcn_sched_barrier(0)
__device__ __forceinline__ int v_st(int k, int c) { const int kk = (k & ~0xC) | ((k & 4) << 1) | ((k & 8) >> 1); return ((kk >> 3) * 4 + (c >> 5)) * 512 + ((kk & 7) * 32 + (c & 31)) * 2; }
__device__ __forceinline__ int v_rd_base(int lane) { return ((lane & 3) << 3) | (((lane >> 2) & 3) << 6) | (((lane >> 4) & 1) << 5) | (((lane >> 5) & 1) << 8); }
constexpr int v_rd_off(int d0, int ks, int half) { return d0 * 512 + ks * 4096 + half * 2048; }
__device__ __forceinline__ int crow(int r, int hi) { return (r & 3) + 8 * (r >> 2) + 4 * hi; }
__device__ __forceinline__ bf16x8 load8(const bf16_t* p) { return *reinterpret_cast<const bf16x8*>(p); }
template <bool SM>
__device__ __forceinline__ void mask_tile(f32x16& p0, f32x16& p1, int dq) {
    const float NEG = SM ? -__builtin_inff() : 0.f;
#pragma unroll
    for (int r = 0; r < 16; ++r) {
        const int c = (r & 3) + 8 * (r >> 2);
        if (dq - c < 0) p0[r] = NEG;
        if (dq - c - 32 < 0) p1[r] = NEG;
    }
}
__device__ __forceinline__ void partialSM(f32x16& p0, f32x16& p1, float& m_reg, float& mn, float& alpha) {
    float pmax = p0[0]; for (int r = 1; r < 16; ++r) pmax = fmaxf(pmax, p0[r]); for (int r = 0; r < 16; ++r) pmax = fmaxf(pmax, p1[r]);
    { auto rr = __builtin_amdgcn_permlane32_swap(__float_as_uint(pmax), __float_as_uint(pmax), false, false);
      pmax = fmaxf(__uint_as_float(rr[0]), __uint_as_float(rr[1])); }
    constexpr float C2 = 1.4426950408889634f * SCALE;
    if (__builtin_expect(__all((pmax - m_reg) * SCALE <= THR), 1)) { mn = m_reg; alpha = 1.f; }
    else { mn = fmaxf(m_reg, pmax); alpha = __builtin_amdgcn_exp2f((m_reg - mn) * C2); m_reg = mn; }
    const float mnL = -mn * C2;
    for (int r = 0; r < 16; ++r) p0[r] = fmaf(p0[r], C2, mnL); for (int r = 0; r < 16; ++r) p1[r] = fmaf(p1[r], C2, mnL);
    for (int r = 0; r < 16; ++r) p0[r] = __builtin_amdgcn_exp2f(p0[r]);
}
template <bool SM>
__device__ __forceinline__ void finishSM(f32x16& p0, f32x16& p1, float alpha, float& l_reg, bf16x8& pa0, bf16x8& pa1, bf16x8& pa2, bf16x8& pa3) {
    if (SM) {
        for (int r = 0; r < 16; ++r) p1[r] = __builtin_amdgcn_exp2f(p1[r]);
        float ps = 0; for (int r = 0; r < 16; ++r) ps += p0[r]; for (int r = 0; r < 16; ++r) ps += p1[r];
        { auto rr = __builtin_amdgcn_permlane32_swap(__float_as_uint(ps), __float_as_uint(ps), false, false);
          ps = __uint_as_float(rr[0]) + __uint_as_float(rr[1]); }
        l_reg = l_reg * alpha + ps;
    }
#define PK4(P, B_, OUT) do { unsigned a0 = cvt_pk_bf16(P[B_+0], P[B_+1]), a1 = cvt_pk_bf16(P[B_+2], P[B_+3]);                          \
        unsigned b0 = cvt_pk_bf16(P[B_+4], P[B_+5]), b1 = cvt_pk_bf16(P[B_+6], P[B_+7]);                                             \
        auto r0 = __builtin_amdgcn_permlane32_swap(a0, b0, false, false); auto r1 = __builtin_amdgcn_permlane32_swap(a1, b1, false, false); \
        u32x4 w = {r0[0], r1[0], r0[1], r1[1]}; OUT = *reinterpret_cast<bf16x8*>(&w); } while (0)
    PK4(p0, 0, pa0); PK4(p0, 8, pa1); PK4(p1, 0, pa2); PK4(p1, 8, pa3);
#undef PK4
}
template <int KB, bool SM>
__device__ __forceinline__ void qkt(f32x16& p0, f32x16& p1, const char* lds, int r32, int hi, const bf16x8* qr, int qxa, const int* qlb) {
    p0 = f32x16{}; p1 = f32x16{};
    int kb[4];
#pragma unroll
    for (int dd = 0; dd < 4; ++dd) kb[dd] = 2 * SHM_V + KB * SHM_K + KSWZ(r32, (dd * 16 + hi * 8) * 2);
#pragma unroll
    for (int d0 = 0; d0 < 8; ++d0) { const char* a = lds + (kb[d0 & 3] ^ ((d0 >> 2) * 128));
        bf16x8 b0 = *reinterpret_cast<const bf16x8*>(a);
        bf16x8 b1 = *reinterpret_cast<const bf16x8*>(a + 32 * 256);
        const bf16x8 qf = SM ? *reinterpret_cast<const bf16x8*>(lds + (qlb[d0 & 3] ^ ((d0 >> 2) * 128))) : qr[d0];
        p0 = __builtin_amdgcn_mfma_f32_32x32x16_bf16(b0, qf, p0, 0, 0, 0);
        p1 = __builtin_amdgcn_mfma_f32_32x32x16_bf16(b1, qf, p1, 0, 0, 0); }
    if (SM) { const char* xb = lds + OFF_X + KB * 1024 + r32 * 16;
        bf16x8 x0 = *reinterpret_cast<const bf16x8*>(xb), x1 = *reinterpret_cast<const bf16x8*>(xb + 512); const bf16x8 qx = *reinterpret_cast<const bf16x8*>(lds + qxa);
        p0 = __builtin_amdgcn_mfma_f32_32x32x16_bf16(x0, qx, p0, 0, 0, 0);
        p1 = __builtin_amdgcn_mfma_f32_32x32x16_bf16(x1, qx, p1, 0, 0, 0); }
}
template <int VB>
__device__ __forceinline__ void pv_tile(f32x16* o, int vb0, bf16x8 pa0, bf16x8 pa1, bf16x8 pa2, bf16x8 pa3) {
#define TRRD(dst, off) asm volatile("ds_read_b64_tr_b16 %0, %1 offset:%2" : "=&v"(dst) : "v"(vb0), "i"(off) : "memory")
#define PV_D0(d0) do { s16x4 l0, l1, l2, l3, h0, h1, h2, h3; constexpr int b_ = VB * SHM_V + v_rd_off(d0, 0, 0); \
        TRRD(l0, b_); TRRD(h0, b_ + 2048); TRRD(l1, b_ + 4096); TRRD(h1, b_ + 6144); TRRD(l2, b_ + 8192); TRRD(h2, b_ + 10240); TRRD(l3, b_ + 12288); TRRD(h3, b_ + 14336); \
        asm volatile("s_waitcnt lgkmcnt(0)" ::: "memory"); SBAR();   \
        o[d0] = __builtin_amdgcn_mfma_f32_32x32x16_bf16(pa0, (bf16x8){l0[0], l0[1], l0[2], l0[3], h0[0], h0[1], h0[2], h0[3]}, o[d0], 0, 0, 0);   \
        o[d0] = __builtin_amdgcn_mfma_f32_32x32x16_bf16(pa1, (bf16x8){l1[0], l1[1], l1[2], l1[3], h1[0], h1[1], h1[2], h1[3]}, o[d0], 0, 0, 0);   \
        o[d0] = __builtin_amdgcn_mfma_f32_32x32x16_bf16(pa2, (bf16x8){l2[0], l2[1], l2[2], l2[3], h2[0], h2[1], h2[2], h2[3]}, o[d0], 0, 0, 0);   \
        o[d0] = __builtin_amdgcn_mfma_f32_32x32x16_bf16(pa3, (bf16x8){l3[0], l3[1], l3[2], l3[3], h3[0], h3[1], h3[2], h3[3]}, o[d0], 0, 0, 0); } while (0)
    PV_D0(0); PV_D0(1); PV_D0(2); PV_D0(3);
#undef PV_D0
#undef TRRD
}
struct BlockRef { unsigned Q, K, V, qxp, kxp, O, Gt; int P0, h; };
struct Seam { bf16x8 qr[8]; bf16x8 st_v0, st_v1, st_k0, st_k1; };
#define ROWB(p, k0, rr) (*(const bf16x8*)(wsb + (size_t)(p) + (size_t)((k0) + (rr)) * 256 + tko))
#define VMW() asm volatile("s_waitcnt vmcnt(0)" ::: "memory")
#define VMWN(n) asm volatile("s_waitcnt vmcnt(%0)" :: "i"(n) : "memory")
#define SLOAD_H(Kp, Vp, Xp, k0) do { S.st_v0 = ROWB(Vp, k0, 0); S.st_v1 = ROWB(Vp, k0, 32);              \
                         S.st_k0 = ROWB(Kp, k0, 0); S.st_k1 = ROWB(Kp, k0, 32); } while (0)
#define XDMA(Xp, k0, bf) do { if (SM && wid == 0) __builtin_amdgcn_global_load_lds((const unsigned*)(wsb + (size_t)(Xp) + (size_t)(k0) * 16 + txo), (LAS unsigned*)(ldsu + OFF_X + (bf) * 1024), 16, 0, 0); } while (0)
#define SWRITE_HK(bf) do { *(bf16x8*)(K_lds + (bf) * SHM_K + kws) = S.st_k0; *(bf16x8*)(K_lds + (bf) * SHM_K + kws + 32 * 256) = S.st_k1; } while (0)
#define SWRITE_HV(bf) do { *(bf16x8*)(V_lds + (bf) * SHM_V + vst0) = S.st_v0; *(bf16x8*)(V_lds + (bf) * SHM_V + vst1) = S.st_v1; } while (0)
#define SWRITE_H(bf) do { SWRITE_HV(bf); SWRITE_HK(bf); } while (0)
template <bool SM>
__device__ __forceinline__ void prime(const BlockRef& cur, char* lds, Seam& S, const char* wsb) {
    int tid = threadIdx.x; asm volatile("" : "+v"(tid));
    const int wid = __builtin_amdgcn_readfirstlane(tid >> 6), lane = tid & 63, r32 = lane & 31, hi = lane >> 5;
    const int sr = tid >> 4, sc = (tid & 15) * 8, kws = KSWZ(sr, sc * 2); char* K_lds = lds + 2 * SHM_V;
    const unsigned tko = (unsigned)(sr * D + sc) * 2u, txo = (unsigned)(tid & 63) * 16u, tqo = (unsigned)((wid * QBLK + r32) * D + hi * 8) * 2u, tqx = (unsigned)(wid * QBLK + r32) * 16u;
    for (int d0 = 0; d0 < 8; ++d0) S.qr[d0] = *(const bf16x8*)(wsb + (size_t)cur.Q + tqo + d0 * 32);
    const unsigned ldsu = (unsigned)(uintptr_t)lds;
    if (SM) {
#pragma unroll
        for (int d0 = 0; d0 < 8; ++d0) *(bf16x8*)(lds + OFF_QL + wid * 8192 + r32 * 256 + ((((d0 * 2) | hi) ^ (r32 & 15)) * 16)) = S.qr[d0]; }
    if (SM) { const bf16x8 qv = *(const bf16x8*)(wsb + (size_t)cur.qxp + tqx); *(bf16x8*)(lds + OFF_QXL + wid * 1024 + (hi ? 512 : r32 * 16)) = hi ? (bf16x8){0, 0, 0, 0, 0, 0, 0, 0} : qv; }
    SLOAD_H(cur.K, cur.V, cur.kxp, 0); XDMA(cur.kxp, 0, 0); VMW(); SWRITE_HK(0);
    __syncthreads();
}
template <bool SM>
__device__ __forceinline__ void block(const BlockRef& cur, const BlockRef& nxt, char* lds, Seam& S, const char* wsb, const float* ret_gain) {
    int tid = threadIdx.x; asm volatile("" : "+v"(tid));
    const int wid = __builtin_amdgcn_readfirstlane(tid >> 6), lane = tid & 63, r32 = lane & 31, hi = lane >> 5;
    const int NT = (cur.P0 + QB - 1) / KVBLK + 1;
    const int qlo = cur.P0 + wid * QBLK, qm = qlo + r32 - 4 * hi;
    char* V_lds = lds; char* K_lds = lds + 2 * SHM_V;
    float* ws = (float*)(lds + OFF_WSF) + wid * 64; float* li_l = ws, * al_l = ws + 32;
    float m_reg = -1e30f, l_reg = 0; f32x16 o[4] = {};
    const int sr = tid >> 4, sc = (tid & 15) * 8, vst0 = v_st(sr, sc), vst1 = v_st(32 + sr, sc), kws = KSWZ(sr, sc * 2);
    const unsigned tko = (unsigned)(sr * D + sc) * 2u, txo = (unsigned)(tid & 63) * 16u, ldsu = (unsigned)(uintptr_t)lds;
    const int qxa = OFF_QXL + wid * 1024 + (hi ? 512 : r32 * 16);
    int qlb[4];
#pragma unroll
    for (int dd = 0; dd < 4; ++dd) qlb[dd] = OFF_QL + wid * 8192 + r32 * 256 + ((((dd * 2) | hi) ^ (r32 & 15)) * 16);
    const int vb0 = (int)(uintptr_t)V_lds + v_rd_base(lane);
    const unsigned Kh = cur.K, Vh = cur.V, Xh = cur.kxp;
#define RESC(a) do { if (SM) { if (__any((a) < 1.f)) { if (hi == 0) al_l[r32] = (a); asm volatile("s_waitcnt lgkmcnt(0)" ::: "memory");              \
                     for (int d_ = 0; d_ < 4; ++d_) for (int r = 0; r < 16; ++r) o[d_][r] *= al_l[crow(r, hi)]; } } } while (0)
#define KBASE(t) ((t) * KVBLK)
#define MASKT(P0_, P1_, t) do { const int kb_ = KBASE(t); if (kb_ + KVBLK - 1 > qlo) mask_tile<SM>(P0_, P1_, qm - kb_); } while (0)
#define PSM(P0_, P1_, mn_, al_) do { if (SM) partialSM(P0_, P1_, m_reg, mn_, al_); } while (0)
    constexpr int NQL = 8;
#define SEAM_K0() do { VMWN(NQL); SWRITE_HK(0); SBAR(); } while (0)
    f32x16 pA0, pA1, pB0, pB1; float mnA = 0, mnB = 0, alA = 1.f, alB = 1.f; bf16x8 pa0, pa1, pa2, pa3;
    SWRITE_HV(0); SBAR();
    if (NT > 1) { SLOAD_H(Kh, Vh, Xh, KBASE(1)); XDMA(Xh, KBASE(1), 1); }
    SBAR(); qkt<0, SM>(pA0, pA1, lds, r32, hi, S.qr, qxa, qlb);
    MASKT(pA0, pA1, 0); PSM(pA0, pA1, mnA, alA);
    if (NT > 1) { VMW(); SWRITE_H(1); }
    __syncthreads();
#define HALF_STEP(PX0, PX1, mnX, alX, PY0, PY1, alY, t, KB, VB, SB) do {                                                      \
        SBAR(); qkt<KB, SM>(PX0, PX1, lds, r32, hi, S.qr, qxa, qlb);                                             \
        finishSM<SM>(PY0, PY1, alY, l_reg, pa0, pa1, pa2, pa3); SBAR();                                                           \
        if ((t) + 1 < NT) { SLOAD_H(Kh, Vh, Xh, KBASE((t) + 1)); XDMA(Xh, KBASE((t) + 1), SB); SBAR(); }                                               \
        pv_tile<VB>(o, vb0, pa0, pa1, pa2, pa3); MASKT(PX0, PX1, (t)); PSM(PX0, PX1, mnX, alX);                                        \
        __syncthreads();                                                                                                      \
        if ((t) + 1 < NT) { VMW(); SWRITE_H(SB); }                                                                          \
        RESC(alX); __syncthreads(); } while (0)
    for (int t = 1; t + 1 < NT; t += 2) {
        HALF_STEP(pB0, pB1, mnB, alB, pA0, pA1, alA, t, 1, 0, 0);
        HALF_STEP(pA0, pA1, mnA, alA, pB0, pB1, alB, t + 1, 0, 1, 1);
    }
    const bool even = (NT & 1) == 0;
    if (even) { SBAR(); qkt<1, SM>(pB0, pB1, lds, r32, hi, S.qr, qxa, qlb); SBAR(); }
    SLOAD_H(nxt.K, nxt.V, nxt.kxp, 0); XDMA(nxt.kxp, 0, 0); SBAR();
    { unsigned tqo = (unsigned)((wid * QBLK + r32) * D + hi * 8) * 2u; asm volatile("" : "+v"(tqo));
#pragma unroll
    for (int d0 = 0; d0 < 8; ++d0) S.qr[d0] = *(const bf16x8*)(wsb + (size_t)nxt.Q + tqo + d0 * 32);
    }
    SBAR();
    finishSM<SM>(pA0, pA1, alA, l_reg, pa0, pa1, pa2, pa3); SBAR();
    pv_tile<0>(o, vb0, pa0, pa1, pa2, pa3);
    if (even) { MASKT(pB0, pB1, NT - 1); PSM(pB0, pB1, mnB, alB); __syncthreads(); RESC(alB);
        finishSM<SM>(pB0, pB1, alB, l_reg, pa0, pa1, pa2, pa3); SBAR(); pv_tile<1>(o, vb0, pa0, pa1, pa2, pa3); }
    SBAR(); SEAM_K0();
    unsigned obase = (unsigned)((wid * QBLK + (lane >> 4)) * DM + (lane & 15) * 8) * 2u; asm volatile("" : "+v"(obase));
    unsigned sbase = (unsigned)(4 * hi * 128 + r32); asm volatile("" : "+v"(sbase));
    unsigned lbase = (unsigned)lane * 16u; asm volatile("" : "+v"(lbase));
    unsigned short* const stg = (unsigned short*)(lds + OFF_QL + wid * 8192);
    char* const Ob = (char*)wsb + (size_t)cur.O;
    if (SM) {
        if (hi == 0) li_l[r32] = l_reg; asm volatile("s_waitcnt lgkmcnt(0)" ::: "memory");
#pragma unroll
        for (int r = 0; r < 16; ++r) { const int c0 = (r & 3) + 8 * (r >> 2); const float rl = __builtin_amdgcn_rcpf(li_l[c0 + 4 * hi]);
#pragma unroll
            for (int d0 = 0; d0 < 4; ++d0) { const float v = o[d0][r] * rl; stg[sbase + c0 * 128 + d0 * 32] = (unsigned short)cvt_pk_bf16(v, 0.f); } }
    } else {
        unsigned gbase = (unsigned)((wid * QBLK + 4 * hi) * 1024 + r32) * 2u; asm volatile("" : "+v"(gbase));
        const char* const Gb = wsb + (size_t)cur.Gt;
        float gn[4];
#pragma unroll
        for (int d0 = 0; d0 < 4; ++d0) gn[d0] = ret_gain[cur.h * 128 + d0 * 32 + r32];
        float gv[16][4];
#pragma unroll
        for (int r = 0; r < 16; ++r) { const int c0 = (r & 3) + 8 * (r >> 2);
#pragma unroll
            for (int d0 = 0; d0 < 4; ++d0) gv[r][d0] = bf2f(*(const bf16_t*)(Gb + gbase + (unsigned)(c0 * 1024 + d0 * 32) * 2u)); }
#pragma unroll
        for (int r = 0; r < 16; ++r) { const int c0 = (r & 3) + 8 * (r >> 2);
            float s = (o[0][r] + o[1][r]) + (o[2][r] + o[3][r]);
            float q = (o[0][r] * o[0][r] + o[1][r] * o[1][r]) + (o[2][r] * o[2][r] + o[3][r] * o[3][r]);
#pragma unroll
            for (int x = 1; x < 32; x <<= 1) { s += __shfl_xor(s, x); q += __shfl_xor(q, x); }
            const float mu = s * (1.f / 128.f), var = fmaxf(q * (1.f / 128.f) - mu * mu, 0.f), rs = rsqrtf(var + EPS);
#pragma unroll
            for (int d0 = 0; d0 < 4; ++d0) { const float g = gv[r][d0];
                const float v = (o[d0][r] - mu) * rs * gn[d0] * g; stg[sbase + c0 * 128 + d0 * 32] = (unsigned short)cvt_pk_bf16(v, 0.f); } }
    }
    asm volatile("s_waitcnt lgkmcnt(0)" ::: "memory");
#pragma unroll
    for (int i = 0; i < 8; ++i) { const u32x4 w = *(const u32x4*)((const char*)stg + lbase + i * 1024); *(u32x4*)(Ob + obase + (unsigned)(i * 4 * DM) * 2u) = w; }
    asm volatile("s_waitcnt lgkmcnt(0)" ::: "memory");
    if (SM) {
#pragma unroll
        for (int d0 = 0; d0 < 8; ++d0) *(bf16x8*)(lds + (qlb[d0 & 3] ^ ((d0 >> 2) * 128))) = S.qr[d0]; }
    if (SM) { unsigned tqx = (unsigned)(wid * QBLK + r32) * 16u; asm volatile("" : "+v"(tqx));
        if (hi == 0) *(bf16x8*)(lds + OFF_QXL + wid * 512 + tqx) = *(const bf16x8*)(wsb + (size_t)nxt.qxp + tqx); }
    __syncthreads();
#undef RESC
#undef KBASE
#undef MASKT
#undef PSM
#undef SEAM_K0
#undef HALF_STEP
}
#undef ROWB
#undef VMW
#undef VMWN
#undef SLOAD_H
#undef XDMA
#undef SWRITE_HK
#undef SWRITE_HV
#undef SWRITE_H

template <bool SM, class MK>
__device__ __forceinline__ void run(int item, int nitems, int istride, char* lds, const char* wsb, const float* ret_gain, const MK& mk) {
    if (item >= nitems) return;
    int pass = 0; Seam S; BlockRef cur = mk(item, 0);
    prime<SM>(cur, lds, S, wsb);
    for (;;) {
        const bool more_pass = pass == 0, more_item = item + istride < nitems, last = !more_pass && !more_item;
        int itn = item, psn = pass + 1; if (!more_pass) { psn = 0; itn = more_item ? item + istride : item; }
        const BlockRef nxt = last ? cur : mk(itn, psn);
        block<SM>(cur, nxt, lds, S, wsb, ret_gain);
        if (last) break;
        cur = nxt; item = itn; pass = psn;
    }
}
}

#ifndef PHMASK
#define PHMASK 0xff
#endif
#define PH(n) ((PHMASK >> (n)) & 1)
#ifndef DUPMASK
#define DUPMASK 0
#endif
#define DUP(n) (((DUPMASK >> (n)) & 1) ? 2 : 1)
struct Args {
    const float *x, *meta, *g1, *w_in, *b_forget, *ret_gain, *w_out, *g2, *w_up, *conv_w, *conv_b, *w_down, *gf;
    float* out; unsigned char* ws;
};

__device__ __forceinline__ float wave_sum(float v) {
#pragma unroll
    for (int o = 1; o < 64; o <<= 1) v += __shfl_xor(v, o);
    return v;
}
struct TrItem { const float* W; bf16_t* WT; const float* kscale; int ldw, K, k0, n0, mode; };
__device__ __forceinline__ TrItem tr_decode(int it, const float* w_in, const float* w_out, const float* w_up, const float* w_down, const float* g2, unsigned char* ws, const float* g1) {
    constexpr int I_IN = (DM / 64) * (NPROJ / 64), I_OUT = (DM / 64) * (DM / 64), I_UP = (DM / 64) * (NUP / 64);
    TrItem t; int r = it;
    if (r < I_IN) { const int nb = NPROJ / 64; t.W = w_in; t.WT = (bf16_t*)(ws + OFF_WTIN); t.kscale = g1; t.ldw = INDIM; t.K = DM; t.k0 = 64 * (r / nb); t.n0 = 64 * (r % nb); t.mode = t.n0 < 2048 ? 1 : 0; return t; } r -= I_IN;
    if (r < I_OUT) { const int nb = DM / 64; t.W = w_out; t.WT = (bf16_t*)(ws + OFF_WTOUT); t.kscale = nullptr; t.ldw = DM; t.K = DM; t.k0 = 64 * (r / nb); t.n0 = 64 * (r % nb); t.mode = 0; return t; } r -= I_OUT;
    if (r < I_UP) { const int nb = NUP / 64; t.W = w_up; t.WT = (bf16_t*)(ws + OFF_WTUP); t.kscale = g2; t.ldw = NUP; t.K = DM; t.k0 = 64 * (r / nb); t.n0 = 64 * (r % nb); t.mode = 2; return t; } r -= I_UP;
    { const int nb = DM / 64; t.W = w_down; t.WT = (bf16_t*)(ws + OFF_WTDN); t.kscale = nullptr; t.ldw = DM; t.K = DFF; t.k0 = 64 * (r / nb); t.n0 = 64 * (r % nb); t.mode = 0; return t; }
}
__device__ __forceinline__ void tr_load(const TrItem& t, f32x4 (&v)[16], int lane) {
    const float* p = t.W + (size_t)(t.k0 + (lane >> 4)) * t.ldw + t.n0 + 4 * (lane & 15);
#pragma unroll
    for (int i = 0; i < 16; ++i) v[i] = __builtin_nontemporal_load((const f32x4*)(p + (size_t)(4 * i) * t.ldw));
}
__device__ __forceinline__ void tr_store(const TrItem& t, const f32x4 (&v)[16], LAS float* scr, int lane) {
#pragma unroll
    for (int i = 0; i < 16; ++i) { LAS float* d = scr + (4 * i + (lane >> 4)) * 65 + 4 * (lane & 15); d[0] = v[i][0]; d[1] = v[i][1]; d[2] = v[i][2]; d[3] = v[i][3]; }
    asm volatile("s_waitcnt lgkmcnt(0)" ::: "memory");
    const int c = lane & 7;
    float ks[8];
#pragma unroll
    for (int j = 0; j < 8; ++j) ks[j] = t.kscale ? t.kscale[t.k0 + 8 * c + j] : 1.f;
#pragma unroll
    for (int q = 0; q < 8; ++q) { const int n = q * 8 + (lane >> 3); const LAS float* s = scr + (8 * c) * 65 + n;
        u32x4 o; o.x = pk2(s[0 * 65] * ks[0], s[1 * 65] * ks[1]); o.y = pk2(s[2 * 65] * ks[2], s[3 * 65] * ks[3]); o.z = pk2(s[4 * 65] * ks[4], s[5 * 65] * ks[5]); o.w = pk2(s[6 * 65] * ks[6], s[7 * 65] * ks[7]);
        int dn = t.n0 + n;
        if (t.mode == 2) { const int ch = dn < DFF ? dn : dn - DFF; dn = 256 * (ch >> 7) + (dn < DFF ? 0 : 128) + (ch & 127); }
        if (t.mode == 1) { const int d = dn & 127; const int p = (d < 64) ? (8 * (d >> 2) + (d & 3)) : (8 * ((d - 64) >> 2) + 4 + (d & 3)); dn = (dn & ~127) + p; }
        *(u32x4*)(t.WT + (size_t)dn * t.K + t.k0 + 8 * c) = o; }
    asm volatile("s_waitcnt lgkmcnt(0)" ::: "memory");
}

__device__ __forceinline__ void tr_run(int it, int it_end, int stride, LAS float* scr, int lane, const float* w_in, const float* w_out, const float* w_up, const float* w_down, const float* g2, unsigned char* ws, const float* g1) {
    f32x4 va[16], vb[16];
    if (it >= it_end) return;
    TrItem ta = tr_decode(it, w_in, w_out, w_up, w_down, g2, ws, g1); tr_load(ta, va, lane);
    for (;;) {
        const int itb = it + stride; TrItem tb = ta; const bool hb = itb < it_end;
        if (hb) { tb = tr_decode(itb, w_in, w_out, w_up, w_down, g2, ws, g1); tr_load(tb, vb, lane); }
        tr_store(ta, va, scr, lane);
        if (!hb) break;
        const int itc = itb + stride; const bool hc = itc < it_end;
        if (hc) { ta = tr_decode(itc, w_in, w_out, w_up, w_down, g2, ws, g1); tr_load(ta, va, lane); }
        tr_store(tb, vb, scr, lane);
        if (!hc) break;
        it = itc;
    }
}
constexpr int TR_N0 = (DM / 64) * (NPROJ / 64);
constexpr int TR_N1 = TR_N0 + (DM / 64) * (DM / 64) + (DM / 64) * (NUP / 64);
constexpr int TR_NIT = TR_N1 + (DFF / 64) * (DM / 64);

#define ss2 ((float*)(ws + OFF_SS2))
#define ss3 ((float*)(ws + OFF_SS3))
#define logf_ ((float*)(ws + OFF_LOGF))
#define cosT ((float*)(ws + OFF_COS))
#define sinT ((float*)(ws + OFF_SIN))
#define dec ((float*)(ws + OFF_DEC))
#define deci ((float*)(ws + OFF_DECI))
#define QX ((bf16_t*)(ws + OFF_QX))
#define KX ((bf16_t*)(ws + OFF_KX))
#define QM ((bf16_t*)(ws + OFF_QM))
#define WtIn ((bf16_t*)(ws + OFF_WTIN))
#define WtOut ((bf16_t*)(ws + OFF_WTOUT))
#define WtUp ((bf16_t*)(ws + OFF_WTUP))
#define WtDn ((bf16_t*)(ws + OFF_WTDN))
#define A1 ((bf16_t*)(ws + OFF_A1))
#define A2 ((bf16_t*)(ws + OFF_A2))
#define ACT ((bf16_t*)(ws + OFF_ACT))
#define SIDE ((bf16_t*)(ws + OFF_SIDE))
#define RQ ((bf16_t*)(ws + OFF_RQ))
#define RK ((bf16_t*)(ws + OFF_RK))
#define RV ((bf16_t*)(ws + OFF_RV))
#define FQ ((bf16_t*)(ws + OFF_FQ))
#define FK ((bf16_t*)(ws + OFF_FK))
#define FV ((bf16_t*)(ws + OFF_FV))
#define GT ((bf16_t*)(ws + OFF_G))
#define MIX ((bf16_t*)(ws + OFF_MIX))

#define XB_TMO      128
#define XB_XCNT(j)  (256  + 64 * (j))
#define XB_XSUB(j)  (1280 + 64 * (j))
#define XB_XGEN(j)  (2304 + 64 * (j))
#define XB_TOP      3328
#define XB_TOPGEN   3392
#define XCD_BAR_WORDS 3456
#define XB_SPIN_CAP (1u << 22)
__device__ __forceinline__ unsigned xb_ld(unsigned* p)              { return __hip_atomic_load(p, __ATOMIC_RELAXED, __HIP_MEMORY_SCOPE_AGENT); }
__device__ __forceinline__ unsigned xb_add(unsigned* p, unsigned v) { return __hip_atomic_fetch_add(p, v, __ATOMIC_RELAXED, __HIP_MEMORY_SCOPE_AGENT); }
__device__ __forceinline__ unsigned xb_xcc_id() { return (unsigned)__builtin_amdgcn_s_getreg((3 << 11) | 20) & 0xFu; }
#define XB_SPIN(cond, bar) do { unsigned _sp = 0; while (cond) { __builtin_amdgcn_s_sleep(1); \
    if ((++_sp & 255u) == 0u) { if (xb_ld(&(bar)[XB_TMO])) break; if (_sp > XB_SPIN_CAP) { atomicAdd(&(bar)[XB_TMO], 1u); break; } } } } while (0)
struct XcdBarrier { unsigned* bar; unsigned x; volatile LAS unsigned* st; };
__device__ __forceinline__ XcdBarrier xcd_barrier_post(unsigned* bar, volatile LAS unsigned* st) {
    XcdBarrier b; b.bar = bar; b.x = xb_xcc_id(); b.st = st;
    if (threadIdx.x == 0) (void)xb_add(&bar[XB_XCNT(b.x)], 1u);
    return b;
}
__device__ __forceinline__ void xcd_barrier_complete(unsigned* bar, unsigned x, unsigned& nloc, unsigned& nx) {
    const unsigned G = gridDim.x * gridDim.y * gridDim.z;
    unsigned sum, cnt, mine, sp = 0u;
    for (;;) {
        sum = 0u; cnt = 0u; mine = 0u;
#pragma unroll
        for (unsigned j = 0; j < 16; ++j) { const unsigned c = xb_ld(&bar[XB_XCNT(j)]); sum += c; cnt += (c > 0u) ? 1u : 0u; mine = (j == x) ? c : mine; }
        if (sum == G) break;
        __builtin_amdgcn_s_sleep(1);
        if ((++sp & 255u) == 0u) { if (xb_ld(&bar[XB_TMO])) break; if (sp > XB_SPIN_CAP) { atomicAdd(&bar[XB_TMO], 1u); break; } }
    }
    nloc = mine > 0u ? mine : 1u; nx = cnt > 0u ? cnt : 1u;
}
__device__ __forceinline__ void xcd_barrier(const XcdBarrier& b) {
    asm volatile("s_waitcnt vmcnt(0)" ::: "memory");
    __syncthreads();
    if (threadIdx.x == 0) {
        unsigned* bar = b.bar;
        __builtin_amdgcn_s_waitcnt(0);
        unsigned nloc = b.st[0], nx = b.st[1];
        if (nloc == 0u) { xcd_barrier_complete(bar, b.x, nloc, nx); b.st[0] = nloc; b.st[1] = nx; }
        const unsigned old = xb_add(&bar[XB_XSUB(b.x)], 1u);
        const unsigned gen = old / nloc;
        if (old + 1u == (gen + 1u) * nloc) {
            __builtin_amdgcn_fence(__ATOMIC_RELEASE, "agent");
            asm volatile("s_waitcnt vmcnt(0)" ::: "memory");
            const unsigned og = xb_add(&bar[XB_TOP], 1u);
            const unsigned tg = og / nx;
            if (og + 1u == (tg + 1u) * nx) xb_add(&bar[XB_TOPGEN], 1u);
            else XB_SPIN(xb_ld(&bar[XB_TOPGEN]) == tg, bar);
            __builtin_amdgcn_fence(__ATOMIC_ACQUIRE, "agent");
            xb_add(&bar[XB_XGEN(b.x)], 1u);
            asm volatile("s_waitcnt vmcnt(0)" ::: "memory");
        } else {
            XB_SPIN(xb_ld(&bar[XB_XGEN(b.x)]) == gen, bar);
            __builtin_amdgcn_fence(__ATOMIC_ACQUIRE, "agent");
            asm volatile("s_waitcnt vmcnt(0)" ::: "memory");
        }
    }
    __syncthreads();
}

__device__ __forceinline__ att::BlockRef mk_block_ref(int it, int ps, bool fox) {
    att::BlockRef r; const int bh = it >> 2, y = it & 3, qb = ps ? 7 - y : y, b = bh >> 3, h = bh & 7;
    r.Q = (unsigned)((fox ? OFF_FQ : OFF_RQ) + ((size_t)bh * SEQ + qb * 256) * 256);
    r.K = (unsigned)((fox ? OFF_FK : OFF_RK) + (size_t)bh * KVP * 256); r.V = (unsigned)((fox ? OFF_FV : OFF_RV) + (size_t)bh * KVP * 256);
    r.P0 = NMETA + qb * 256; r.qxp = (unsigned)(OFF_QX + ((size_t)bh * KVP + r.P0) * 16); r.kxp = (unsigned)(OFF_KX + (size_t)bh * KVP * 16);
    const size_t trow = (size_t)b * SEQ + qb * 256; r.O = (unsigned)(OFF_MIX + (trow * DM + (fox ? 1024 : 0) + h * 128) * 2);
    r.Gt = (unsigned)(OFF_G + (trow * 1024 + h * 128) * 2); r.h = h; return r;
}

__global__ void __launch_bounds__(512, 2) mk_fwd(Args a) {
    extern __shared__ __attribute__((aligned(16))) unsigned char lds[];
    cg::grid_group grid = cg::this_grid();
    LAS unsigned char* L = (LAS unsigned char*)lds;
    const int G = gridDim.x, bx = blockIdx.x;
    const int NGW = G * 8, NGT = G * 512;
#define PHASE_TID() int tid = threadIdx.x; asm volatile("" : "+v"(tid)); const int lane = tid & 63, wave = __builtin_amdgcn_readfirstlane(tid >> 6); const int gw = bx * 8 + wave, gt = bx * 512 + tid; (void)lane; (void)gw; (void)gt;
    unsigned char* ws = a.ws;
    volatile LAS unsigned* bst = (volatile LAS unsigned*)(L + LDS_BYTES - 16);
    if (threadIdx.x == 0) { bst[0] = 0u; bst[1] = 0u; }
    __syncthreads();
    const XcdBarrier xbar = xcd_barrier_post((unsigned*)(ws + OFF_H1M), bst);
    if (a.ws == nullptr) grid.sync();


#if PH(0)
    for (int rep_ = 0; rep_ < DUP(0); ++rep_) { PHASE_TID(); if (rep_) __syncthreads();
    {
        LAS float* wf = (LAS float*)(L + 73728);
#pragma unroll
        for (int i = 0; i < 4; ++i) { const int k = tid + 512 * i; const f32x4 lo = *(const f32x4*)(a.w_in + (size_t)k * INDIM + NPROJ), hi4 = *(const f32x4*)(a.w_in + (size_t)k * INDIM + NPROJ + 4);
#pragma unroll
            for (int h = 0; h < 4; ++h) { wf[h * DM + k] = lo[h]; wf[(4 + h) * DM + k] = hi4[h]; } }
        __syncthreads();
        f32x4 vn[8];
        if (gw < MREAL + NMETA) { const float* xr = gw < MREAL ? a.x + (size_t)gw * DM : a.meta + (size_t)(gw - MREAL) * DM;
#pragma unroll
            for (int j = 0; j < 8; ++j) vn[j] = __builtin_nontemporal_load((const f32x4*)xr + lane + 64 * j); }
        for (int row = gw; row < MREAL + NMETA; row += NGW) {
            f32x4 v[8]; float s = 0.f;
#pragma unroll
            for (int j = 0; j < 8; ++j) { v[j] = vn[j]; s += (v[j][0] * v[j][0] + v[j][1] * v[j][1]) + (v[j][2] * v[j][2] + v[j][3] * v[j][3]); }
            { const int rn = row + NGW; if (rn < MREAL + NMETA) { const float* xr = rn < MREAL ? a.x + (size_t)rn * DM : a.meta + (size_t)(rn - MREAL) * DM;
#pragma unroll
                for (int j = 0; j < 8; ++j) vn[j] = __builtin_nontemporal_load((const f32x4*)xr + lane + 64 * j); } }
            const float rstd = rsqrtf(wave_sum(s) * (1.f / DM) + EPS);
            if (lane == 0 && row < MREAL) ((float*)(ws + OFF_IRS))[row] = 1.f / rstd;
            float fa[8] = {0, 0, 0, 0, 0, 0, 0, 0};
#pragma unroll
            for (int j = 0; j < 8; ++j) { const f32x4 gg = ((const f32x4*)a.g1)[lane + 64 * j]; v[j] = v[j] * rstd;
                u32x2 w; w.x = cvt_pk_bf16(v[j][0], v[j][1]); w.y = cvt_pk_bf16(v[j][2], v[j][3]);
                ((u32x2*)(A1 + (size_t)row * DM))[lane + 64 * j] = w;
                v[j] = v[j] * gg;
#pragma unroll
                for (int h = 0; h < 8; ++h) { const f32x4 wv = *(const LAS f32x4*)(wf + h * DM + 4 * (lane + 64 * j)); fa[h] += (v[j][0] * wv[0] + v[j][1] * wv[1]) + (v[j][2] * wv[2] + v[j][3] * wv[3]); } }
#pragma unroll
            for (int h = 0; h < 8; ++h) fa[h] = wave_sum(fa[h]);
            if (lane < 8) { float f = fa[0];
#pragma unroll
                for (int h = 1; h < 8; ++h) f = (lane == h) ? fa[h] : f;
                const float z = f + a.b_forget[lane];
                logf_[row * 8 + lane] = fminf(z, 0.f) - log1pf(__expf(-fabsf(z))); }
        }
        __syncthreads();
        tr_run(gw, TR_N0, NGW, (LAS float*)(L + wave * 16640), lane, a.w_in, a.w_out, a.w_up, a.w_down, a.g2, ws, a.g1);
        for (int i = gt; i < LTOT * 64; i += NGT) { const int pos = i >> 6, f = i & 63;
            const float inv = exp2f(-(float)f * (13.287712379549449f / 64.f));
            float sn, cs; sincosf((float)pos * inv, &sn, &cs); cosT[i] = cs; sinT[i] = sn; }
        for (int i = gt; i < NH * LTOT; i += NGT) { const int h = i / LTOT, pos = i - h * LTOT;
            const float lg = log1pf(-exp2f(-5.f - (float)h));
            dec[i] = expf(lg * (float)pos); deci[i] = expf(-lg * (float)pos) * 0.08838834764831845f; }
        for (int i = gt; i < MPAD; i += NGT) ss2[i] = 0.f;
        for (int i = gt; i < MREAL; i += NGT) ss3[i] = 0.f;
        for (int i = gt; i < (MPAD - MREAL - NMETA) * DM / 8; i += NGT) { ((u32x4*)(A1 + (size_t)(MREAL + NMETA) * DM))[i] = (u32x4){0, 0, 0, 0}; ((u32x4*)(A2 + (size_t)(MREAL + NMETA) * DM))[i] = (u32x4){0, 0, 0, 0}; }
        for (int i = gt; i < 32 * 48 * 16; i += NGT) { const int bh = i / (48 * 16), r = i - bh * (48 * 16); const size_t o = ((size_t)bh * KVP + LTOT) * 128 + (size_t)r * 8;
            *(u32x4*)(RK + o) = (u32x4){0, 0, 0, 0}; *(u32x4*)(RV + o) = (u32x4){0, 0, 0, 0}; *(u32x4*)(FK + o) = (u32x4){0, 0, 0, 0}; *(u32x4*)(FV + o) = (u32x4){0, 0, 0, 0}; }
    }
    }
#endif
    xcd_barrier(xbar);

#if PH(1)
    for (int rep_ = 0; rep_ < DUP(1); ++rep_) { PHASE_TID(); if (rep_) __syncthreads();
    if (bx >= G - 32) {
        const int bh = bx - (G - 32), b = bh >> 3, h = bh & 7;
        LAS float* sc = (LAS float*)L;
        float v[5]; float run = 0.f;
#pragma unroll
        for (int j = 0; j < 5; ++j) { const int p = tid * 5 + j; float lf = 0.f;
            if (p < LTOT) { const int row = p < NMETA ? MREAL + p : b * SEQ + (p - NMETA); lf = logf_[row * 8 + h]; }
            run += lf; v[j] = run; }
        float incl = run;
#pragma unroll
        for (int o = 1; o < 64; o <<= 1) { const float t = __shfl_up(incl, o); if (lane >= o) incl += t; }
        if (lane == 63) sc[wave] = incl;
        __syncthreads();
        float base = incl - run;
        for (int w = 0; w < wave; ++w) base += sc[w];
#pragma unroll
        for (int j = 0; j < 5; ++j) { const int p = tid * 5 + j;
            if (p < KVP) { u32x4 qv = {0, 0, 0, 0}, kv = {0, 0, 0, 0};
                if (p < LTOT) { const float g = (base + v[j]) * 11.313708498984761f;
                    const unsigned g1 = f2bf(g); const float r1 = g - bf2f(g1); const unsigned g2 = f2bf(r1); const float r2 = r1 - bf2f(g2); const unsigned g3 = f2bf(r2);
                    qv = (u32x4){0x3F803F80u, 0x3F80u | (g1 << 16), g2 | (g3 << 16), 0u};
                    kv = (u32x4){(g1 ^ 0x8000u) | ((g2 ^ 0x8000u) << 16), (g3 ^ 0x8000u) | (0x3F80u << 16), 0x3F803F80u, 0u}; }
                *(u32x4*)(QX + ((size_t)bh * KVP + p) * 8) = qv; *(u32x4*)(KX + ((size_t)bh * KVP + p) * 8) = kv; } }
        __syncthreads();
    }
    {
        pg8::Gemm g{A1, WtIn, MPAD, NPROJ, DM}; pg8::StaticOrder S; S.init(MPAD, NPROJ, G, bx);
        pg8::EpiProj E{ws};
        pg8::gemm_phase<pg8::EpiProj>(L, g, S, E);
    }
    { constexpr int NU1 = (MPAD / 256) * (NPROJ / 256); const int first_idle = NU1 - 3 * G;
      if (first_idle > 0 && first_idle < G) { if (bx >= first_idle) tr_run(TR_N0 + (bx - first_idle) * 8 + wave, TR_N1, (G - first_idle) * 8, (LAS float*)(L + wave * 16640), lane, a.w_in, a.w_out, a.w_up, a.w_down, a.g2, ws, a.g1); }
      else tr_run(TR_N0 + gw, TR_N1, NGW, (LAS float*)(L + wave * 16640), lane, a.w_in, a.w_out, a.w_up, a.w_down, a.g2, ws, a.g1); }
    }
#endif
    xcd_barrier(xbar);

#if PH(2)
    for (int rep_ = 0; rep_ < DUP(2); ++rep_) { PHASE_TID(); if (rep_) __syncthreads();
#ifndef NO_META
    if (bx >= G - 2) {
        const int h = tid >> 6, i = (tid >> 2) & 15, dq = tid & 3;
        LAS float* cumL = (LAS float*)(L + 140000);
        LAS float* scL = (LAS float*)(L + 98304);
        if (tid < 8) { float c = 0.f; for (int j = 0; j < 16; ++j) { c += logf_[(MREAL + j) * 8 + tid]; cumL[tid * 16 + j] = c; } }
        __syncthreads();
        const float cumi = cumL[h * 16 + i];
        { const int mode = bx == G - 1 ? 1 : 0;
            { const bf16_t* Kg = mode ? FK : RK; const bf16_t* Vg = mode ? FV : RV;
#pragma unroll
              for (int c4 = 0; c4 < 4; ++c4) { const int c = tid + 512 * c4, hh = c >> 8, w = c & 255;
                  const u32x4 kq = *(const u32x4*)(Kg + (size_t)hh * KVP * 128 + w * 8), vq = *(const u32x4*)(Vg + (size_t)hh * KVP * 128 + w * 8);
                  *(LAS u32x4*)(L + c * 16) = kq; *(LAS u32x4*)(L + 32768 + c * 16) = vq; } }
            __syncthreads();
            const bf16_t* q = QM + (size_t)((mode * 8 + h) * 16 + i) * 128 + dq * 32;
            const LAS unsigned char* Kp = L + h * 4096 + dq * 64; const LAS unsigned char* Vp = L + 32768 + h * 4096 + dq * 64;
            u32x4 qv[4];
#pragma unroll
            for (int d8 = 0; d8 < 4; ++d8) qv[d8] = *(const u32x4*)(q + d8 * 8);
            float mx = -1e30f;
#pragma unroll 1
            for (int j = 0; j < 16; ++j) { float sdot = 0.f;
#pragma unroll
                for (int d8 = 0; d8 < 4; ++d8) { const u32x4 kv = *(const LAS u32x4*)(Kp + j * 256 + d8 * 16);
#pragma unroll
                    for (int e = 0; e < 4; ++e) sdot += bf2f(qv[d8][e] & 0xffffu) * bf2f(kv[e] & 0xffffu) + bf2f(qv[d8][e] >> 16) * bf2f(kv[e] >> 16); }
                sdot += __shfl_xor(sdot, 1); sdot += __shfl_xor(sdot, 2);
                if (mode) { sdot = sdot * att::SCALE + cumi - cumL[h * 16 + j]; if (j > i) sdot = -1e30f; mx = fmaxf(mx, sdot); } else { if (j > i) sdot = 0.f; }
                scL[tid * 17 + j] = sdot; }
            float o[32];
#pragma unroll
            for (int d = 0; d < 32; ++d) o[d] = 0.f;
            float l = 0.f;
#pragma unroll 1
            for (int j = 0; j < 16; ++j) { float p = scL[tid * 17 + j]; if (mode) { p = (j > i) ? 0.f : __expf(p - mx); l += p; }
#pragma unroll
                for (int d8 = 0; d8 < 4; ++d8) { const u32x4 vv = *(const LAS u32x4*)(Vp + j * 256 + d8 * 16);
#pragma unroll
                    for (int e = 0; e < 4; ++e) { o[d8 * 8 + 2 * e] += p * bf2f(vv[e] & 0xffffu); o[d8 * 8 + 2 * e + 1] += p * bf2f(vv[e] >> 16); } } }
            bf16_t* dst = MIX + (size_t)(MREAL + i) * DM + (mode ? 1024 : 0) + h * 128 + dq * 32;
            if (mode) { const float rl = 1.f / l;
#pragma unroll
                for (int d = 0; d < 32; d += 2) *(unsigned*)(dst + d) = cvt_pk_bf16(o[d] * rl, o[d + 1] * rl);
            } else { float sm = 0.f, qq = 0.f;
#pragma unroll
                for (int d = 0; d < 32; ++d) { sm += o[d]; qq += o[d] * o[d]; }
                sm += __shfl_xor(sm, 1); sm += __shfl_xor(sm, 2); qq += __shfl_xor(qq, 1); qq += __shfl_xor(qq, 2);
                const float mu = sm * (1.f / 128.f), var = fmaxf(qq * (1.f / 128.f) - mu * mu, 0.f), rs = rsqrtf(var + EPS);
                const bf16_t* gp = GT + (size_t)(MREAL + i) * 1024 + h * 128 + dq * 32; const float* gn = a.ret_gain + h * 128 + dq * 32;
#pragma unroll
                for (int d = 0; d < 32; d += 2) *(unsigned*)(dst + d) = cvt_pk_bf16((o[d] - mu) * rs * gn[d] * bf2f(gp[d]), (o[d + 1] - mu) * rs * gn[d + 1] * bf2f(gp[d + 1])); }
            __syncthreads();
        }
        __syncthreads();
    }
#endif
#ifndef NO_ATT
    {
#if defined(ONLY_FOX)
        const bool fox = true;
#elif defined(ONLY_RET)
        const bool fox = false;
#else
        const bool fox = bx < G / 2;
#endif
        struct MkF { __device__ __forceinline__ att::BlockRef operator()(int it, int ps) const { return mk_block_ref(it, ps, true); } };
        struct MkR { __device__ __forceinline__ att::BlockRef operator()(int it, int ps) const { return mk_block_ref(it, ps, false); } };
        if (fox) att::run<true>(bx, 128, G / 2, (char*)lds, (const char*)ws, a.ret_gain, MkF());
        else att::run<false>(bx - G / 2, 128, G / 2, (char*)lds, (const char*)ws, a.ret_gain, MkR());
    }
#endif
    }
#endif
    xcd_barrier(xbar);

#if PH(3)
    for (int rep_ = 0; rep_ < DUP(3); ++rep_) { PHASE_TID(); if (rep_) __syncthreads();
    if (bx < 128) {
        const int fr = lane & 15, fq = lane >> 4, col0 = bx * 16;
        const bf16_t* ap = MIX + (size_t)(MREAL + fr) * DM + wave * 256 + 8 * fq; const bf16_t* bp = WtOut + (size_t)(col0 + fr) * DM + wave * 256 + 8 * fq;
        bf16x8 av[8], bv[8];
#pragma unroll
        for (int i = 0; i < 8; ++i) { av[i] = *(const bf16x8*)(ap + 32 * i); bv[i] = *(const bf16x8*)(bp + 32 * i); }
        f32x4 acc = {0, 0, 0, 0};
#pragma unroll
        for (int i = 0; i < 8; ++i) acc = __builtin_amdgcn_mfma_f32_16x16x32_bf16(av[i], bv[i], acc, 0, 0, 0);
        LAS f32x4* red = (LAS f32x4*)L; red[wave * 64 + lane] = acc;
        __syncthreads();
        if (wave == 0) {
            f32x4 t = red[lane];
#pragma unroll
            for (int w = 1; w < 8; ++w) t += red[w * 64 + lane];
#pragma unroll
            for (int j = 0; j < 4; ++j) { const int row = fq * 4 + j, col = col0 + fr; const float hv = a.meta[(size_t)row * DM + col] + t[j];
                A2[(size_t)(MREAL + row) * DM + col] = (bf16_t)f2bf(hv);
                float q = hv * hv; q += __shfl_xor(q, 1); q += __shfl_xor(q, 2); q += __shfl_xor(q, 4); q += __shfl_xor(q, 8);
                if (fr == 0 && rep_ + 1 == DUP(3)) atomicAdd(ss2 + MREAL + row, q); }
        }
        __syncthreads();
    }
    {
        pg8::Gemm g{MIX, WtOut, MREAL, DM, DM}; pg8::StaticOrder S; S.init(MREAL, DM, G, bx, 8);
        pg8::EpiOut E{A1, (const float*)(ws + OFF_IRS), A2, ss2, rep_ + 1 < DUP(3)};
        pg8::gemm_phase<pg8::EpiOut>(L, g, S, E);
    }
    }
#endif
    xcd_barrier(xbar);

#if PH(4)
    for (int rep_ = 0; rep_ < DUP(4); ++rep_) { PHASE_TID(); if (rep_) __syncthreads();
    {
        pg8::Gemm g{A2, WtUp, MPAD, NUP, DM}; pg8::StaticOrder S; S.init(MPAD, NUP, G, bx);
        pg8::EpiUp E{ACT, SIDE, ss2, a.conv_w, a.conv_b, L};
        pg8::gemm_phase<pg8::EpiUp>(L, g, S, E);
    }
    { constexpr int NU4 = (MPAD / 256) * (NUP / 256); const int first_idle = NU4 - 5 * G;
      if (first_idle > 0 && first_idle < G) { if (bx >= first_idle) tr_run(TR_N1 + (bx - first_idle) * 8 + wave, TR_NIT, (G - first_idle) * 8, (LAS float*)(L + wave * 16640), lane, a.w_in, a.w_out, a.w_up, a.w_down, a.g2, ws, a.g1); }
      else tr_run(TR_N1 + gw, TR_NIT, NGW, (LAS float*)(L + wave * 16640), lane, a.w_in, a.w_out, a.w_up, a.w_down, a.g2, ws, a.g1); }
    }
#endif
    xcd_barrier(xbar);

#if PH(6)
    for (int rep_ = 0; rep_ < DUP(6); ++rep_) { PHASE_TID(); if (rep_) __syncthreads();
    {
        pg8::Gemm g{ACT, WtDn, MREAL, DM, DFF}; pg8::StaticOrder S; S.init(MREAL, DM, G, bx, 8);
        { pg8::Unit u0;
          if (S.next(0, u0)) {
            const int rg = u0.pn, gq = 4 * u0.pm + (rg >> 1), t = rg & 1;
            const bool bstart = (gq & 31) == 0;
            const int r0 = gq * 4 + t;
            const int r1 = t ? gq * 4 : (bstart ? 128 * 4 + 3 : (gq - 1) * 4 + 3);
            const int r2 = t ? (bstart ? 128 * 4 + 3 : (gq - 1) * 4 + 3) : (bstart ? 128 * 4 + 2 : (gq - 1) * 4 + 2);
            for (int c8 = tid; c8 < DFF / 8; c8 += 512) {
                const int ch = c8 * 8, col = 256 * (ch >> 7) + (ch & 127);
                const u32x4 g0r = *(const u32x4*)(SIDE + (size_t)r0 * NUP + col), v0r = *(const u32x4*)(SIDE + (size_t)r0 * NUP + col + 128);
                const u32x4 g1r = *(const u32x4*)(SIDE + (size_t)r1 * NUP + col), v1r = *(const u32x4*)(SIDE + (size_t)r1 * NUP + col + 128);
                const u32x4 g2r = *(const u32x4*)(SIDE + (size_t)r2 * NUP + col), v2r = *(const u32x4*)(SIDE + (size_t)r2 * NUP + col + 128);
                f32x4 wgv[3][2], wvv[3][2], bgv[2], bvv[2];
#pragma unroll
                for (int k = 0; k < 3; ++k)
#pragma unroll
                    for (int q = 0; q < 2; ++q) { wgv[k][q] = *(const f32x4*)(a.conv_w + k * NUP + ch + 4 * q); wvv[k][q] = *(const f32x4*)(a.conv_w + k * NUP + DFF + ch + 4 * q); }
#pragma unroll
                for (int q = 0; q < 2; ++q) { bgv[q] = *(const f32x4*)(a.conv_b + ch + 4 * q); bvv[q] = *(const f32x4*)(a.conv_b + DFF + ch + 4 * q); }
                float res[8];
#pragma unroll
                for (int j = 0; j < 8; ++j) { const int w = j >> 1, sh = (j & 1) * 16, q = j >> 2, e = j & 3;
                    const float ga = bf2f((g2r[w] >> sh) & 0xffffu), gb = bf2f((g1r[w] >> sh) & 0xffffu), gc = bf2f((g0r[w] >> sh) & 0xffffu);
                    const float va = bf2f((v2r[w] >> sh) & 0xffffu), vb = bf2f((v1r[w] >> sh) & 0xffffu), vc = bf2f((v0r[w] >> sh) & 0xffffu);
                    const float yg = bgv[q][e] + wgv[0][q][e] * ga + wgv[1][q][e] * gb + wgv[2][q][e] * gc;
                    const float yv = bvv[q][e] + wvv[0][q][e] * va + wvv[1][q][e] * vb + wvv[2][q][e] * vc;
                    res[j] = silu_f(yg) * yv; }
                u32x4 w; w.x = cvt_pk_bf16(res[0], res[1]); w.y = cvt_pk_bf16(res[2], res[3]); w.z = cvt_pk_bf16(res[4], res[5]); w.w = cvt_pk_bf16(res[6], res[7]);
                st_wt16(ACT + (size_t)(gq * 64 + t) * DFF + ch, w);
            }
            asm volatile("s_waitcnt vmcnt(0)" ::: "memory");
            __syncthreads();
            if (tid == 0) { unsigned* c = (unsigned*)(ws + OFF_H1M + 24576) + 64 * u0.pm;
                __hip_atomic_fetch_add(c, 1u, __ATOMIC_RELAXED, __HIP_MEMORY_SCOPE_AGENT);
                unsigned sp = 0; while (__hip_atomic_load(c, __ATOMIC_RELAXED, __HIP_MEMORY_SCOPE_AGENT) < 8u) { __builtin_amdgcn_s_sleep(4); if (++sp > (1u << 20)) break; } }
            __syncthreads();
          } }
        pg8::EpiDown E{a.out, A2, ss3, (unsigned*)(ws + OFF_H1M + 16384), a.gf};
        pg8::gemm_phase<pg8::EpiDown>(L, g, S, E);
    }
    }
#endif
}

extern "C" void kernel_launch(void* const* d_in, const int* in_sizes, int n_in, void* d_out, int out_size, void* d_ws, size_t ws_size, hipStream_t stream) {
    static int grid = 0;
    if (grid == 0) {
        if (n_in != 13 || out_size != MREAL * DM || ws_size < WS_END) { fprintf(stderr, "kernel_launch: unexpected shapes (n_in %d out %d ws %zu, need %zu)\n", n_in, out_size, ws_size, (size_t)WS_END); grid = -1; return; }
        int dev = 0, cus = 0, per_cu = 0;
        (void)hipGetDevice(&dev);
        (void)hipDeviceGetAttribute(&cus, hipDeviceAttributeMultiprocessorCount, dev);
        (void)hipFuncSetAttribute((const void*)mk_fwd, hipFuncAttributeMaxDynamicSharedMemorySize, LDS_BYTES);
        (void)hipOccupancyMaxActiveBlocksPerMultiprocessor(&per_cu, (const void*)mk_fwd, 512, LDS_BYTES);
        (void)hipGetLastError();
        if (cus != 256 || per_cu < 1) fprintf(stderr, "kernel_launch: cus %d per_cu %d\n", cus, per_cu);
        grid = 256;
    }
    if (grid < 0) return;
    Args a{};
    a.x = (const float*)d_in[0]; a.meta = (const float*)d_in[1]; a.g1 = (const float*)d_in[2]; a.w_in = (const float*)d_in[3]; a.b_forget = (const float*)d_in[4];
    a.ret_gain = (const float*)d_in[5]; a.w_out = (const float*)d_in[6]; a.g2 = (const float*)d_in[7]; a.w_up = (const float*)d_in[8]; a.conv_w = (const float*)d_in[9];
    a.conv_b = (const float*)d_in[10]; a.w_down = (const float*)d_in[11]; a.gf = (const float*)d_in[12];
    a.out = (float*)d_out; a.ws = (unsigned char*)d_ws;
    if (hipMemsetAsync((char*)d_ws + OFF_H1M, 0, 16384 + 2 * 32 * 256, stream) != hipSuccess) { fprintf(stderr, "kernel_launch: memset failed\n"); return; }
    void* args[] = {&a};
    hipError_t e = hipLaunchCooperativeKernel((const void*)mk_fwd, dim3(grid), dim3(512), args, LDS_BYTES, stream);
    if (e != hipSuccess) fprintf(stderr, "kernel_launch: cooperative launch failed: %s\n", hipGetErrorString(e));
}
```
